# Optimizing an MI355X kernel written in HIP

```python
import jax, jax.numpy as jnp
from jax import lax
import numpy as np

D_MODEL = 1024
BATCH = 4
SEQ = 8192
DEPTH = 2

PLE_DIM = 256
D_MIX = D_MODEL
HEAD_DIM = 64
RMS_EPS = 1e-6

CONV_W = D_MIX // 4
CONV_K = 3

NSA_HEADS = 6
NSA_KV_HEADS = 2
NSA_GROUP = NSA_HEADS // NSA_KV_HEADS
NSA_W = NSA_HEADS * HEAD_DIM
NSA_KV_W = NSA_KV_HEADS * HEAD_DIM
CMP_BLOCK = 32
CMP_STRIDE = 16
SLC_BLOCK = 64
SLC_TOPK = 16
WIN = 512
Q_BLOCK = 128
FORCE_SCORE = 1e4

DIL_PAIRS = ((128, 1), (512, 4), (2048, 16))
DIL_HEADS_PER_PAIR = 2
DIL_HEADS = DIL_HEADS_PER_PAIR * len(DIL_PAIRS)
DIL_W = DIL_HEADS * HEAD_DIM
DIL_BLOCK = 128

IN_SIZES = ((CONV_W,) * 4
            + (NSA_W,) + (NSA_KV_W,) * 6
            + (NSA_HEADS * 3, NSA_W)
            + (DIL_W,) * 4)
D_IN = sum(IN_SIZES)

kernel_name = "hymba_conv_nsa_dilated_hybrid"


def _rmsnorm(x, g):
    x32 = x.astype(jnp.float32)
    y = x32 * lax.rsqrt(jnp.mean(x32 * x32, axis=-1, keepdims=True) + RMS_EPS)
    return (y * g.astype(jnp.float32)).astype(x.dtype)


def _masked_softmax(s, mask):
    s = jnp.where(mask, s.astype(jnp.float32), -jnp.inf)
    m = jnp.max(s, axis=-1, keepdims=True)
    m = jnp.where(jnp.isfinite(m), m, 0.0)
    e = jnp.where(mask, jnp.exp(s - m), 0.0)
    den = jnp.sum(e, axis=-1, keepdims=True)
    return e / jnp.maximum(den, 1e-30), m, den


def _short_conv(u, w, b):
    y = lax.conv_general_dilated(
        u, w[:, None, :].astype(u.dtype), window_strides=(1,), padding=((CONV_K - 1, 0),),
        dimension_numbers=("NWC", "WIO", "NWC"), feature_group_count=u.shape[-1])
    return y + b.astype(u.dtype)


def _nsa(q, kc_raw, vc_raw, ks_raw, vs_raw, kw_raw, vw_raw, gates, pe, w1, w2):
    B, T, G, R, E = q.shape
    scale = E ** -0.5
    n_cmp = (T - CMP_BLOCK) // CMP_STRIDE + 1
    cmp_start = jnp.arange(n_cmp) * CMP_STRIDE
    cmp_idx = cmp_start[:, None] + jnp.arange(CMP_BLOCK)[None, :]

    def compress(a, pe_, w1_, w2_):
        blk = a[:, cmp_idx] + pe_[None, None, :, None, :].astype(a.dtype)
        flat = jnp.moveaxis(blk, 3, 2).reshape(B, n_cmp, G, CMP_BLOCK * E)
        return jax.nn.silu(flat @ w1_) @ w2_

    k_cmp = compress(kc_raw, pe[0], w1[0], w2[0])
    v_cmp = compress(vc_raw, pe[1], w1[1], w2[1])
    cmp_last = cmp_start + CMP_BLOCK - 1
    n_slc = T // SLC_BLOCK
    slc_start = jnp.arange(n_slc) * SLC_BLOCK
    overlap = ((cmp_start[:, None] < slc_start[None, :] + SLC_BLOCK)
               & (cmp_start[:, None] + CMP_BLOCK > slc_start[None, :])).astype(jnp.float32)
    k_slc = ks_raw.reshape(B, n_slc, SLC_BLOCK, G, E).transpose(0, 3, 1, 2, 4)
    v_slc = vs_raw.reshape(B, n_slc, SLC_BLOCK, G, E).transpose(0, 3, 1, 2, 4)
    top = min(SLC_TOPK, n_slc)
    b_ix = jnp.arange(B)[:, None, None, None]
    g_ix = jnp.arange(G)[None, None, :, None]
    k_win = jnp.pad(kw_raw, ((0, 0), (WIN, 0), (0, 0), (0, 0)))
    v_win = jnp.pad(vw_raw, ((0, 0), (WIN, 0), (0, 0), (0, 0)))

    def block(qi):
        q0 = qi * Q_BLOCK
        t = q0 + jnp.arange(Q_BLOCK)
        qb = lax.dynamic_slice_in_dim(q, q0, Q_BLOCK, axis=1)
        gb = lax.dynamic_slice_in_dim(gates, q0, Q_BLOCK, axis=1)
        s_c = jnp.einsum("bqgrd,bngd->bqgrn", qb, k_cmp) * scale
        m_c = (cmp_last[None, :] <= t[:, None])[None, :, None, None, :]
        p_c, _, _ = _masked_softmax(s_c, m_c)
        o_c = jnp.einsum("bqgrn,bngd->bqgrd", p_c.astype(qb.dtype), v_cmp)
        imp = jnp.einsum("bqgrn,ns->bqgs", p_c, overlap)
        blk = jnp.arange(n_slc)[None, :]
        cur = (t // SLC_BLOCK)[:, None]
        forced = (blk == 0) | (blk == cur) | (blk == cur - 1)
        causal = blk * SLC_BLOCK <= t[:, None]
        imp = jnp.where(forced[None, :, None, :], FORCE_SCORE, imp)
        imp = jnp.where(causal[None, :, None, :], imp, -1.0)
        _, sel = lax.top_k(imp, top)
        k_sel = k_slc[b_ix, g_ix, sel]
        v_sel = v_slc[b_ix, g_ix, sel].reshape(B, Q_BLOCK, G, top * SLC_BLOCK, E)
        pos = sel[..., None] * SLC_BLOCK + jnp.arange(SLC_BLOCK)
        m_s = (pos <= t[None, :, None, None, None]).reshape(B, Q_BLOCK, G, 1, top * SLC_BLOCK)
        s_s = jnp.einsum("bqgrd,bqgkld->bqgrkl", qb, k_sel).reshape(
            B, Q_BLOCK, G, R, top * SLC_BLOCK) * scale
        p_s, _, _ = _masked_softmax(s_s, m_s)
        o_s = jnp.einsum("bqgrk,bqgkd->bqgrd", p_s.astype(qb.dtype), v_sel)
        kw = lax.dynamic_slice_in_dim(k_win, q0, WIN + Q_BLOCK, axis=1)
        vw = lax.dynamic_slice_in_dim(v_win, q0, WIN + Q_BLOCK, axis=1)
        kpos = q0 - WIN + jnp.arange(WIN + Q_BLOCK)
        dist = t[:, None] - kpos[None, :]
        m_w = ((dist >= 0) & (dist < WIN) & (kpos[None, :] >= 0))[None, :, None, None, :]
        s_w = jnp.einsum("bqgrd,bkgd->bqgrk", qb, kw) * scale
        p_w, _, _ = _masked_softmax(s_w, m_w)
        o_w = jnp.einsum("bqgrk,bkgd->bqgrd", p_w.astype(qb.dtype), vw)
        return gb[..., 0:1] * o_c + gb[..., 1:2] * o_s + gb[..., 2:3] * o_w

    out = lax.map(block, jnp.arange(T // Q_BLOCK))
    return jnp.moveaxis(out, 0, 1).reshape(B, T, G * R * E)


def _dilated_group(q, k, v, window, dil):
    B, T, H, E = q.shape
    L = T // dil
    Lp = -(-L // DIL_BLOCK) * DIL_BLOCK
    nb = Lp // DIL_BLOCK
    steps = window // dil

    def sub(a):
        a = a.reshape(B, L, dil, H, E).transpose(0, 2, 3, 1, 4)
        a = jnp.pad(a, ((0, 0), (0, 0), (0, 0), (0, Lp - L), (0, 0)))
        return a.reshape(B, dil, H, nb, DIL_BLOCK, E)

    def with_prev(a):
        prev = jnp.concatenate([jnp.zeros_like(a[:, :, :, :1]), a[:, :, :, :-1]], axis=3)
        return jnp.concatenate([prev, a], axis=4)

    qs = sub(q)
    kc = with_prev(sub(k))
    vc = with_prev(sub(v))
    s = jnp.einsum("bdhnqe,bdhnke->bdhnqk", qs, kc) * (E ** -0.5)
    a_i = jnp.arange(DIL_BLOCK)
    c_i = jnp.arange(2 * DIL_BLOCK)
    dist = a_i[:, None] + DIL_BLOCK - c_i[None, :]
    j = jnp.arange(nb)[:, None, None] * DIL_BLOCK - DIL_BLOCK + c_i[None, None, :]
    mask = (dist[None] >= 0) & (dist[None] <= steps) & (j >= 0)
    p, m, den = _masked_softmax(s, mask)
    o = jnp.einsum("bdhnqk,bdhnke->bdhnqe", p.astype(v.dtype), vc)
    lse = (m + jnp.log(den))[..., 0]
    o = o.reshape(B, dil, H, Lp, E)[:, :, :, :L].transpose(0, 3, 1, 2, 4).reshape(B, T, H, E)
    lse = lse.reshape(B, dil, H, Lp)[:, :, :, :L].transpose(0, 3, 1, 2).reshape(B, T, H)
    return o, lse


def _dilated_mixer(q, k, v):
    B, T, _, E = q.shape
    outs, lses = [], []
    for gi, (window, dil) in enumerate(DIL_PAIRS):
        sl = slice(gi * DIL_HEADS_PER_PAIR, (gi + 1) * DIL_HEADS_PER_PAIR)
        o, lse = _dilated_group(q[:, :, sl], k[:, :, sl], v[:, :, sl], window, dil)
        outs.append(o)
        lses.append(lse)
    alpha = jax.nn.softmax(jnp.stack(lses, axis=0), axis=0)
    y = jnp.concatenate([alpha[gi][..., None].astype(outs[gi].dtype) * outs[gi]
                         for gi in range(len(DIL_PAIRS))], axis=2)
    return y.reshape(B, T, DIL_W)


def setup_inputs(seed: int = 0) -> dict:
    key = jax.random.key(seed)
    ks = jax.random.split(key, 13)
    f32 = jnp.float32
    x = jax.random.normal(ks[0], (BATCH, SEQ, D_MODEL), f32)
    p = jax.random.normal(ks[1], (DEPTH, BATCH, SEQ, PLE_DIM), f32)
    norm_mix = 1.0 + 0.05 * jax.random.normal(ks[2], (DEPTH, D_MODEL), f32)
    w_in = jax.random.normal(ks[3], (DEPTH, D_MODEL, D_IN), f32) * D_MODEL ** -0.5
    conv_w = jax.random.normal(ks[4], (DEPTH, CONV_K, CONV_W), f32) * CONV_K ** -0.5
    conv_b = 0.02 * jax.random.normal(ks[5], (DEPTH, CONV_W), f32)
    cmp_pe = 0.5 * jax.random.normal(ks[6], (DEPTH, 2, CMP_BLOCK, HEAD_DIM), f32)
    cmp_w1 = jax.random.normal(ks[7], (DEPTH, 2, CMP_BLOCK * HEAD_DIM, HEAD_DIM), f32) * (CMP_BLOCK * HEAD_DIM) ** -0.5
    cmp_w2 = jax.random.normal(ks[8], (DEPTH, 2, HEAD_DIM, HEAD_DIM), f32) * HEAD_DIM ** -0.5
    w_out = jax.random.normal(ks[9], (DEPTH, D_MIX, D_MODEL), f32) * D_MIX ** -0.5
    w_ple_gate = jax.random.normal(ks[10], (DEPTH, D_MODEL, D_MODEL), f32) * D_MODEL ** -0.5
    w_ple_proj = jax.random.normal(ks[11], (DEPTH, PLE_DIM, D_MODEL), f32) * PLE_DIM ** -0.5
    norm_final = 1.0 + 0.05 * jax.random.normal(ks[12], (D_MODEL,), f32)
    return {"x": x, "p": p, "norm_mix": norm_mix, "w_in": w_in, "conv_w": conv_w,
            "conv_b": conv_b, "cmp_pe": cmp_pe, "cmp_w1": cmp_w1, "cmp_w2": cmp_w2,
            "w_out": w_out, "w_ple_gate": w_ple_gate, "w_ple_proj": w_ple_proj,
            "norm_final": norm_final}


def reference(x, p, norm_mix, w_in, conv_w, conv_b, cmp_pe, cmp_w1, cmp_w2,
              w_out, w_ple_gate, w_ple_proj, norm_final):
    B, T, _ = x.shape
    E = HEAD_DIM
    split_points = np.cumsum(IN_SIZES)[:-1].tolist()
    h = x
    for i in range(DEPTH):
        xn = _rmsnorm(h, norm_mix[i])
        u = xn @ w_in[i]
        (a_b, a_c, a_h, a_z,
         n_q, n_kc, n_vc, n_ks, n_vs, n_kw, n_vw, n_g, n_z,
         d_q, d_k, d_v, d_z) = jnp.split(u, split_points, axis=-1)
        y_a = a_b * _short_conv(a_c * a_h, conv_w[i], conv_b[i]) * jax.nn.silu(a_z)
        kv = lambda a: a.reshape(B, T, NSA_KV_HEADS, E)
        gates = jax.nn.sigmoid(n_g.astype(jnp.float32)).astype(u.dtype).reshape(
            B, T, NSA_KV_HEADS, NSA_GROUP, 3)
        y_b = _nsa(n_q.reshape(B, T, NSA_KV_HEADS, NSA_GROUP, E), kv(n_kc), kv(n_vc),
                   kv(n_ks), kv(n_vs), kv(n_kw), kv(n_vw), gates,
                   cmp_pe[i], cmp_w1[i], cmp_w2[i]) * jax.nn.silu(n_z)
        hd = lambda a: a.reshape(B, T, DIL_HEADS, E)
        y_c = _dilated_mixer(hd(d_q), hd(d_k), hd(d_v)) * jax.nn.silu(d_z)
        h = h + jnp.concatenate([y_a, y_b, y_c], axis=-1) @ w_out[i]
        gate = jax.nn.sigmoid((h @ w_ple_gate[i]).astype(jnp.float32)).astype(h.dtype)
        h = h + gate * (p[i] @ w_ple_proj[i])
    return _rmsnorm(h, norm_final)
```

```cpp
#define ONE_LAUNCH 1
#include <hip/hip_runtime.h>
#include <hip/hip_cooperative_groups.h>
#include <cstdio>
#include <cstdint>
namespace cg = cooperative_groups;
__device__ __forceinline__ int otid() { int t = threadIdx.x; asm volatile("" : "+v"(t)); return t; }
namespace pg8 {
#define PG8_LAS __attribute__((address_space(3)))
typedef unsigned short bf16_t;
typedef short bf16x8 __attribute__((ext_vector_type(8)));
typedef float f32x4 __attribute__((ext_vector_type(4)));
typedef unsigned u32x4 __attribute__((ext_vector_type(4)));
constexpr int BM = 256, BK = 64, HALF = 128, HTB = HALF * BK * 2  , STAGE_BYTES = 8 * HTB, NXCD = 8, WGM = 8;

__host__ __device__ __forceinline__ int lds_byte(int r, int c) { const int st = (r >> 4) * 2 + (c >> 5), rr = r & 15, cc = c & 31, ob = rr * 64 + cc * 2; return st * 1024 + (ob ^ (((ob >> 9) & 1) << 5)); }
__host__ __device__ __forceinline__ void stage_rc(int b, int& R, int& C) { const int st = b / 1024, sb = b % 1024, swz = sb ^ (((sb >> 9) & 1) << 5); R = (st >> 1) * 16 + swz / 64; C = (st & 1) * 32 + (swz % 64) / 2; }
__host__ __device__ __forceinline__ int perm32(int rho) { const int n = rho >> 4, i = rho & 15; return 8 * (i >> 2) + 4 * n + (i & 3); }

struct Unit { int pm, pn; };
struct Gemm { const bf16_t* A; const bf16_t* Bt; int M, N, K; };

struct StaticOrder {
    int nM, nN, nwg, G, c;
    __host__ __device__ void init(int M, int N, int G_, int c_) { nM = M / BM; nN = N / BM; nwg = nM * nN; G = G_; c = c_; }
    __host__ __device__ bool next(int i, Unit& u) const {
        const long L = (long)i * G + c; if (L >= nwg) return false;
        int wgid = (int)L; { const int q = nwg / NXCD, r = nwg % NXCD, xcd = wgid % NXCD, off = wgid / NXCD; wgid = (xcd < r ? xcd * (q + 1) : r * (q + 1) + (xcd - r) * q) + off; }
        const int nig = WGM * nN, gid = wgid / nig, fm = gid * WGM, gsz = (nM - fm) < WGM ? (nM - fm) : WGM;
        u.pm = fm + ((wgid % nig) % gsz); u.pn = (wgid % nig) / gsz; return true;
    }
    __device__ __forceinline__ void a_ready(const Unit&) const {}
    __device__ __forceinline__ void done(const Unit&) const {}
};

template <class Epi, class Sched, bool ALIGN_EPI = false, bool SP2 = false>
__device__ __forceinline__ void gemm_phase(PG8_LAS unsigned char* lds, const Gemm g, const Sched& S, const Epi& E) {
    const int tid = otid(), wid = __builtin_amdgcn_readfirstlane(tid >> 6), lane = tid & 63, wr = wid >> 2, wc = wid & 3, fr = lane & 15, fq = lane >> 4;
    const int K = g.K, nt = K / BK;
    unsigned voffA[2], voffB[2];
#pragma unroll
    for (int i = 0; i < 2; ++i) { int R, C; stage_rc(tid * 16 + i * 8192, R, C); const int Rb = Epi::PERM ? ((R & ~31) + perm32(R & 31)) : R;
        voffA[i] = (unsigned)(R * K + C) * 2u; voffB[i] = (unsigned)(Rb * K + C) * 2u; }
    const size_t kstep = (size_t)(BK * 2);
    const size_t hstep = (size_t)HALF * K * 2;
    const size_t tstep = 2 * hstep;
    const unsigned ldsw = (unsigned)wid * 1024u;
    const int aoff = lds_byte(wr * 64 + fr, fq * 8), boff = lds_byte(wc * 32 + fr, fq * 8);
#define PG8_SA(b, h) (((b) * 2 + (h)) * HTB)
#define PG8_SB(b, h) ((4 + (b) * 2 + (h)) * HTB)
#define PG8_STAGE(bufoff, gbase, voff) do { _Pragma("unroll") for (int _i = 0; _i < 2; ++_i) \
        __builtin_amdgcn_global_load_lds((const unsigned*)((const char*)(gbase) + (voff)[_i]), (PG8_LAS unsigned*)(lds + (bufoff) + ldsw + _i * 8192), 16, 0, 0); } while (0)
#define PG8_LDA(dst, b, h) do { _Pragma("unroll") for (int m = 0; m < 4; ++m) _Pragma("unroll") for (int k = 0; k < 2; ++k) dst[m][k] = *(const PG8_LAS bf16x8*)(lds + PG8_SA(b, h) + aoff + m * 2048 + k * 1024); } while (0)
#define PG8_LDB(dst, b, h) do { _Pragma("unroll") for (int n = 0; n < 2; ++n) _Pragma("unroll") for (int k = 0; k < 2; ++k) dst[n][k] = *(const PG8_LAS bf16x8*)(lds + PG8_SB(b, h) + boff + n * 2048 + k * 1024); } while (0)
#define PG8_MMA(ai, bj, At, Bt) do { __builtin_amdgcn_s_setprio(1); _Pragma("unroll") for (int m = 0; m < 4; ++m) _Pragma("unroll") for (int n = 0; n < 2; ++n) _Pragma("unroll") for (int k = 0; k < 2; ++k) \
        acc[ai][bj][m][n] = __builtin_amdgcn_mfma_f32_16x16x32_bf16(Bt[n][k], At[m][k], acc[ai][bj][m][n], 0, 0, 0); __builtin_amdgcn_s_setprio(0); } while (0)
#define PG8_WAIT_V(n) asm volatile("s_waitcnt vmcnt(" #n ")" ::: "memory")
#define PG8_WAIT_L(n) asm volatile("s_waitcnt lgkmcnt(" #n ")" ::: "memory")
#define PG8_BAR __builtin_amdgcn_s_barrier()
#define PG8_SCHED __builtin_amdgcn_sched_barrier(0)
    Unit cur, nxt; int ui = 0;
    if (!S.next(0, cur)) return;
    f32x4 acc[2][2][4][2];
#pragma unroll
    for (int a = 0; a < 2; ++a)
#pragma unroll
        for (int b = 0; b < 2; ++b)
#pragma unroll
            for (int m = 0; m < 4; ++m)
#pragma unroll
                for (int n = 0; n < 2; ++n) acc[a][b][m][n] = (f32x4){0.f, 0.f, 0.f, 0.f};
    if constexpr (Epi::INIT) E.init(acc, cur, wr, wc, fr, fq);
    bf16x8 At[4][2], B0[2][2], B1[2][2];
    const char* cA = (const char*)g.A + (size_t)cur.pm * tstep; const char* cB = (const char*)g.Bt + (size_t)cur.pn * tstep;
    S.a_ready(cur);
    if constexpr (SP2) {
        PG8_STAGE(PG8_SB(0, 0), cB, voffB); PG8_STAGE(PG8_SB(0, 1), cB + hstep, voffB); PG8_STAGE(PG8_SA(0, 0), cA, voffA); PG8_STAGE(PG8_SA(0, 1), cA + hstep, voffA);
        if (wr == 1) PG8_BAR;
        PG8_WAIT_V(2); PG8_BAR;
        PG8_STAGE(PG8_SB(1, 0), cB + kstep, voffB); PG8_STAGE(PG8_SA(1, 0), cA + kstep, voffA); PG8_STAGE(PG8_SB(1, 1), cB + hstep + kstep, voffB);
        PG8_WAIT_V(6); PG8_BAR;
    } else {
        PG8_STAGE(PG8_SB(0, 0), cB, voffB); PG8_STAGE(PG8_SA(0, 0), cA, voffA); PG8_STAGE(PG8_SB(0, 1), cB + hstep, voffB); PG8_STAGE(PG8_SA(0, 1), cA + hstep, voffA);
        if (wr == 1) PG8_BAR;
        PG8_WAIT_V(4); PG8_BAR;
        PG8_STAGE(PG8_SB(1, 0), cB + kstep, voffB); PG8_STAGE(PG8_SA(1, 0), cA + kstep, voffA); PG8_STAGE(PG8_SB(1, 1), cB + hstep + kstep, voffB);
        PG8_WAIT_V(6); PG8_BAR;
    }
    for (;;) {
        const bool has_next = S.next(ui + 1, nxt);
        const char* nA = has_next ? (const char*)g.A + (size_t)nxt.pm * tstep : cA; const char* nB = has_next ? (const char*)g.Bt + (size_t)nxt.pn * tstep : cB;
        for (int t = 0; t < nt; t += 2) {
            const bool last = (t == nt - 2);
            const char* a1 = cA + (size_t)(t + 1) * kstep;
            const char* a2 = last ? nA : cA + (size_t)(t + 2) * kstep; const char* b2 = last ? nB : cB + (size_t)(t + 2) * kstep;
            const char* a3 = a2 + kstep; const char* b3 = b2 + kstep;
            if (last && has_next) S.a_ready(nxt);
            if constexpr (SP2) {
            PG8_LDB(B0, 0, 0); PG8_LDB(B1, 0, 1); PG8_SCHED; PG8_LDA(At, 0, 0); PG8_STAGE(PG8_SA(1, 1), a1 + hstep, voffA);
            PG8_WAIT_V(8); PG8_WAIT_L(0); PG8_BAR; PG8_MMA(0, 0, At, B0); PG8_MMA(0, 1, At, B1); PG8_BAR; PG8_SCHED;
            PG8_LDA(At, 0, 1); PG8_STAGE(PG8_SB(0, 0), b2, voffB); PG8_STAGE(PG8_SB(0, 1), b2 + hstep, voffB); PG8_STAGE(PG8_SA(0, 0), a2, voffA);
            PG8_WAIT_V(8); PG8_WAIT_L(0); PG8_BAR; PG8_MMA(1, 0, At, B0); PG8_MMA(1, 1, At, B1); PG8_BAR; PG8_SCHED;
            PG8_LDB(B0, 1, 0); PG8_LDB(B1, 1, 1); PG8_SCHED; PG8_LDA(At, 1, 0); PG8_STAGE(PG8_SA(0, 1), a2 + hstep, voffA);
            PG8_WAIT_V(8); PG8_WAIT_L(0); PG8_BAR; PG8_MMA(0, 0, At, B0); PG8_MMA(0, 1, At, B1); PG8_BAR; PG8_SCHED;
            PG8_LDA(At, 1, 1); PG8_STAGE(PG8_SB(1, 0), b3, voffB); PG8_STAGE(PG8_SB(1, 1), b3 + hstep, voffB); PG8_STAGE(PG8_SA(1, 0), a3, voffA);
            PG8_WAIT_V(8); PG8_WAIT_L(0); PG8_BAR; PG8_MMA(1, 0, At, B0); PG8_MMA(1, 1, At, B1); PG8_BAR; PG8_SCHED;
            } else {
            PG8_LDB(B0, 0, 0); PG8_SCHED; PG8_LDA(At, 0, 0); PG8_STAGE(PG8_SA(1, 1), a1 + hstep, voffA);
            PG8_WAIT_L(8); PG8_BAR; PG8_WAIT_L(0); PG8_MMA(0, 0, At, B0); PG8_BAR; PG8_SCHED;
            PG8_LDB(B1, 0, 1); PG8_STAGE(PG8_SB(0, 0), b2, voffB);
            PG8_BAR; PG8_WAIT_L(0); PG8_MMA(0, 1, At, B1); PG8_BAR;
            PG8_LDA(At, 0, 1); PG8_STAGE(PG8_SA(0, 0), a2, voffA);
            PG8_BAR; PG8_WAIT_L(0); PG8_MMA(1, 0, At, B0); PG8_BAR; PG8_SCHED;
            PG8_STAGE(PG8_SB(0, 1), b2 + hstep, voffB);
            PG8_WAIT_V(6); PG8_BAR; PG8_MMA(1, 1, At, B1); PG8_BAR;
            PG8_LDB(B0, 1, 0); PG8_SCHED; PG8_LDA(At, 1, 0); PG8_STAGE(PG8_SA(0, 1), a2 + hstep, voffA);
            PG8_WAIT_L(8); PG8_BAR; PG8_WAIT_L(0); PG8_MMA(0, 0, At, B0); PG8_BAR; PG8_SCHED;
            PG8_LDB(B1, 1, 1); PG8_STAGE(PG8_SB(1, 0), b3, voffB);
            PG8_BAR; PG8_WAIT_L(0); PG8_MMA(0, 1, At, B1); PG8_BAR;
            PG8_LDA(At, 1, 1); PG8_STAGE(PG8_SA(1, 0), a3, voffA);
            PG8_BAR; PG8_WAIT_L(0); PG8_MMA(1, 0, At, B0); PG8_BAR; PG8_SCHED;
            PG8_STAGE(PG8_SB(1, 1), b3 + hstep, voffB);
            PG8_WAIT_V(6); PG8_BAR; PG8_MMA(1, 1, At, B1); PG8_BAR;
            }
        }
        if constexpr (ALIGN_EPI) { if (wr == 0) PG8_BAR; }
        if constexpr (!Epi::AFTER_DRAIN) { E(acc, cur, wr, wc, fr, fq); S.done(cur); }
        if (!has_next) break;
#pragma unroll
        for (int a = 0; a < 2; ++a)
#pragma unroll
            for (int b = 0; b < 2; ++b)
#pragma unroll
                for (int m = 0; m < 4; ++m)
#pragma unroll
                    for (int n = 0; n < 2; ++n) acc[a][b][m][n] = (f32x4){0.f, 0.f, 0.f, 0.f};
        if constexpr (Epi::INIT) E.init(acc, nxt, wr, wc, fr, fq);
        cur = nxt; cA = nA; cB = nB; ++ui;
        if constexpr (ALIGN_EPI) { if (wr == 1) PG8_BAR; }
    }
    PG8_WAIT_V(0);
    if constexpr (!ALIGN_EPI) { if (wr == 0) PG8_BAR; }
    PG8_BAR;
    if constexpr (Epi::AFTER_DRAIN) { E.fused(acc, cur, wr, wc, fr, fq, lds, wid, lane); S.done(cur); }
#undef PG8_SA
#undef PG8_SB
#undef PG8_STAGE
#undef PG8_LDA
#undef PG8_LDB
#undef PG8_MMA
#undef PG8_WAIT_V
#undef PG8_WAIT_L
#undef PG8_BAR
#undef PG8_SCHED
}
}

#define LAS __attribute__((address_space(3)))
typedef unsigned short bf16_t;
typedef short bf16x8 __attribute__((ext_vector_type(8)));
typedef float f32x4 __attribute__((ext_vector_type(4)));
typedef unsigned u32x4 __attribute__((ext_vector_type(4)));
typedef unsigned u32x2 __attribute__((ext_vector_type(2)));

constexpr int BATCH = 4, SEQ = 8192, DM = 1024, MTOK = BATCH * SEQ, PLE = 256, DEPTH = 2;
constexpr int DIN = 4114, NU = 4352;
constexpr int C_AB = 0, C_AC = 256, C_AH = 512, C_AZ = 768, C_NQ = 1024, C_KC = 1408, C_VC = 1536, C_KS = 1664, C_VS = 1792,
              C_KW = 1920, C_VW = 2048, C_NZ = 2176, C_DQ = 2560, C_DK = 2944, C_DV = 3328, C_DZ = 3712, C_NG = 4096;
constexpr int NCMP = 511, NCMP_P = 512;
constexpr float RMS_EPS = 1e-6f;
constexpr float SS_SCALE = 4294967296.0f, SS_INV = 1.0f / 4294967296.0f / 1024.0f;
constexpr float LOG2E = 1.4426950408889634f;
constexpr float SC2 = 0.125f * LOG2E;
constexpr float NEGBIG = -1e30f;

constexpr size_t MiB = 1u << 20;
constexpr size_t WS_U = 0;
constexpr size_t WS_H1 = 0;
constexpr size_t WS_H1B = 128 * MiB;
constexpr size_t WS_PP = 192 * MiB;
constexpr size_t WS_XY = 272 * MiB;
constexpr size_t WS_PB = 336 * MiB;
constexpr size_t WS_OD = 368 * MiB;
constexpr size_t WS_LSE = 392 * MiB;
constexpr size_t WS_KC = 393 * MiB;
constexpr size_t WS_VC = WS_KC + 512 * 1024;
constexpr size_t WS_C1 = 394 * MiB;
constexpr size_t WS_SS = 394 * MiB + 65536;
constexpr size_t WS_WIN = 395 * MiB;
constexpr size_t WS_WOUT = 412 * MiB;
constexpr size_t WS_WGATE = 416 * MiB;
constexpr size_t WS_WPROJ = 420 * MiB;
constexpr size_t WS_W1T = 421 * MiB;
constexpr size_t WS_W2T = 422 * MiB;
constexpr size_t WS_BAR = 423 * MiB;
constexpr size_t WS_H2B = 424 * MiB;
constexpr size_t WS_END = 488 * MiB;

struct Params {
    const float *x, *p, *norm_mix, *w_in, *conv_w, *conv_b, *cmp_pe, *cmp_w1, *cmp_w2, *w_out, *w_gate, *w_proj, *norm_final;
    float* out; unsigned char* ws; int ph_lo, ph_hi;
};

typedef float f32x2_t __attribute__((ext_vector_type(2))); typedef __bf16 bf16x2_t __attribute__((ext_vector_type(2)));
__device__ __forceinline__ unsigned pk_bf16(float lo, float hi) { const f32x2_t v = {lo, hi}; const bf16x2_t b = __builtin_convertvector(v, bf16x2_t); return __builtin_bit_cast(unsigned, b); }
__device__ __forceinline__ float bf_lo(unsigned w) { return __uint_as_float(w << 16); }
__device__ __forceinline__ float bf_hi(unsigned w) { return __uint_as_float(w & 0xffff0000u); }
__device__ __forceinline__ float bf2f(bf16_t v) { return __uint_as_float(((unsigned)v) << 16); }
__device__ __forceinline__ float fexp2(float x) { return __builtin_amdgcn_exp2f(x); }
__device__ __forceinline__ float frcp(float x) { return __builtin_amdgcn_rcpf(x); }
__device__ __forceinline__ float sigmoidf_(float x) { return frcp(1.0f + fexp2(-x * LOG2E)); }
__device__ __forceinline__ float siluf_(float x) { return x * sigmoidf_(x); }
__device__ __forceinline__ float wave_sum(float v) {
#pragma unroll
    for (int o = 1; o < 64; o <<= 1) v += __shfl_xor(v, o);
    return v;
}

struct EpiU {
    static constexpr bool PERM = true, AFTER_DRAIN = false, INIT = false;
    bf16_t* O; int ldc;
    __device__ __forceinline__ void operator()(const pg8::f32x4 (&acc)[2][2][4][2], const pg8::Unit& u, int wr, int wc, int fr, int fq) const {
        const int row0 = u.pm * 256 + wr * 64 + fr; const int col0 = u.pn * 256 + wc * 32 + 8 * fq;
#pragma unroll
        for (int ai = 0; ai < 2; ++ai)
#pragma unroll
            for (int m = 0; m < 4; ++m) { bf16_t* rowp = O + (size_t)(row0 + ai * 128 + m * 16) * ldc + col0;
#pragma unroll
                for (int bj = 0; bj < 2; ++bj) { const pg8::f32x4 v0 = acc[ai][bj][m][0], v1 = acc[ai][bj][m][1];
                    u32x4 w; w.x = pk_bf16(v0[0], v0[1]); w.y = pk_bf16(v0[2], v0[3]); w.z = pk_bf16(v1[0], v1[1]); w.w = pk_bf16(v1[2], v1[3]);
                    *(u32x4*)(rowp + bj * 128) = w; } }
    }
};
struct EpiUS {
    static constexpr bool PERM = true, AFTER_DRAIN = false, INIT = false;
    bf16_t* O; int ldc; const unsigned long long* ss;
    __device__ __forceinline__ void operator()(const pg8::f32x4 (&acc)[2][2][4][2], const pg8::Unit& u, int wr, int wc, int fr, int fq) const {
        const int row0 = u.pm * 256 + wr * 64 + fr; const int col0 = u.pn * 256 + wc * 32 + 8 * fq;
#pragma unroll
        for (int ai = 0; ai < 2; ++ai)
#pragma unroll
            for (int m = 0; m < 4; ++m) { const int row = row0 + ai * 128 + m * 16; bf16_t* rowp = O + (size_t)row * ldc + col0;
                const float rs = 1.0f / sqrtf((float)ss[row] * SS_INV + RMS_EPS);
#pragma unroll
                for (int bj = 0; bj < 2; ++bj) { const pg8::f32x4 v0 = acc[ai][bj][m][0] * rs, v1 = acc[ai][bj][m][1] * rs;
                    u32x4 w; w.x = pk_bf16(v0[0], v0[1]); w.y = pk_bf16(v0[2], v0[3]); w.z = pk_bf16(v1[0], v1[1]); w.w = pk_bf16(v1[2], v1[3]);
                    *(u32x4*)(rowp + bj * 128) = w; } }
    }
};
struct EpiRes {
    static constexpr bool PERM = true, AFTER_DRAIN = false, INIT = true;
    const bf16_t* baseb; bf16_t* outb;
    __device__ __forceinline__ void init(pg8::f32x4 (&acc)[2][2][4][2], const pg8::Unit& u, int wr, int wc, int fr, int fq) const {
        const int row0 = u.pm * 256 + wr * 64 + fr; const int col0 = u.pn * 256 + wc * 32 + 8 * fq;
#pragma unroll
        for (int ai = 0; ai < 2; ++ai)
#pragma unroll
            for (int m = 0; m < 4; ++m) { const size_t ro = (size_t)(row0 + ai * 128 + m * 16) * DM + col0;
#pragma unroll
                for (int bj = 0; bj < 2; ++bj) { const u32x4 w = *(const u32x4*)(baseb + ro + bj * 128);
                    acc[ai][bj][m][0] = (f32x4){bf_lo(w.x), bf_hi(w.x), bf_lo(w.y), bf_hi(w.y)}; acc[ai][bj][m][1] = (f32x4){bf_lo(w.z), bf_hi(w.z), bf_lo(w.w), bf_hi(w.w)}; } }
    }
    __device__ __forceinline__ void operator()(const pg8::f32x4 (&acc)[2][2][4][2], const pg8::Unit& u, int wr, int wc, int fr, int fq) const {
        const int row0 = u.pm * 256 + wr * 64 + fr; const int col0 = u.pn * 256 + wc * 32 + 8 * fq;
#pragma unroll
        for (int ai = 0; ai < 2; ++ai)
#pragma unroll
            for (int m = 0; m < 4; ++m) { const size_t ro = (size_t)(row0 + ai * 128 + m * 16) * DM + col0;
#pragma unroll
                for (int bj = 0; bj < 2; ++bj) { const f32x4 v0 = acc[ai][bj][m][0], v1 = acc[ai][bj][m][1];
                    u32x4 w; w.x = pk_bf16(v0[0], v0[1]); w.y = pk_bf16(v0[2], v0[3]); w.z = pk_bf16(v1[0], v1[1]); w.w = pk_bf16(v1[2], v1[3]);
                    *(u32x4*)(outb + ro + bj * 128) = w; } }
    }
};
struct EpiGate {
    static constexpr bool PERM = true, AFTER_DRAIN = false, INIT = false;
    const bf16_t* h1; const bf16_t* pp; bf16_t* xg; unsigned long long* ss;
    __device__ __forceinline__ void operator()(const pg8::f32x4 (&acc)[2][2][4][2], const pg8::Unit& u, int wr, int wc, int fr, int fq) const {
        const int row0 = u.pm * 256 + wr * 64 + fr; const int col0 = u.pn * 256 + wc * 32 + 8 * fq;
#pragma unroll
        for (int ai = 0; ai < 2; ++ai)
#pragma unroll
            for (int m = 0; m < 4; ++m) { const int row = row0 + ai * 128 + m * 16; const size_t ro = (size_t)row * DM + col0; float sq = 0.f;
#pragma unroll
                for (int bj = 0; bj < 2; ++bj) { const size_t off = ro + bj * 128;
                    const u32x4 hw = *(const u32x4*)(h1 + off); const u32x4 pw = *(const u32x4*)(pp + off); const f32x4 a0 = acc[ai][bj][m][0], a1 = acc[ai][bj][m][1];
                    float v[8];
                    v[0] = bf_lo(hw.x) + sigmoidf_(a0[0]) * bf_lo(pw.x); v[1] = bf_hi(hw.x) + sigmoidf_(a0[1]) * bf_hi(pw.x);
                    v[2] = bf_lo(hw.y) + sigmoidf_(a0[2]) * bf_lo(pw.y); v[3] = bf_hi(hw.y) + sigmoidf_(a0[3]) * bf_hi(pw.y);
                    v[4] = bf_lo(hw.z) + sigmoidf_(a1[0]) * bf_lo(pw.z); v[5] = bf_hi(hw.z) + sigmoidf_(a1[1]) * bf_hi(pw.z);
                    v[6] = bf_lo(hw.w) + sigmoidf_(a1[2]) * bf_lo(pw.w); v[7] = bf_hi(hw.w) + sigmoidf_(a1[3]) * bf_hi(pw.w);
                    sq += ((v[0] * v[0] + v[1] * v[1]) + (v[2] * v[2] + v[3] * v[3])) + ((v[4] * v[4] + v[5] * v[5]) + (v[6] * v[6] + v[7] * v[7]));
                    u32x4 w; w.x = pk_bf16(v[0], v[1]); w.y = pk_bf16(v[2], v[3]); w.z = pk_bf16(v[4], v[5]); w.w = pk_bf16(v[6], v[7]); *(u32x4*)(xg + off) = w; }
                sq += __shfl_xor(sq, 16); sq += __shfl_xor(sq, 32);
                if (fq == 0) atomicAdd(ss + row, (unsigned long long)(sq * SS_SCALE)); }
    }
};

__device__ __forceinline__ int win_src_col(int n) { return n < 2176 ? n : (n < 4096 ? n + 18 : (n < 4114 ? 2176 + (n - 4096) : -1)); }

__device__ __forceinline__ void transpose_item(const float* W, int ldw, int nsrc, int mode, bf16_t* Wt, int K, int n0, int k0, LAS float* tile, const float* gk = nullptr) {
    const int tid = otid();
    { const int nn = tid & 63; const int np = n0 + nn; const int src = mode ? win_src_col(np) : (np < nsrc ? np : -1);
      const float qs = (mode && ((np >= C_NQ && np < C_NQ + 384) || (np >= C_DQ && np < C_DQ + 384))) ? SC2 : 1.0f;
#pragma unroll
      for (int i = 0; i < 8; ++i) { const int kk = i * 8 + (tid >> 6); tile[kk * 65 + nn] = src >= 0 ? W[(size_t)(k0 + kk) * ldw + src] * (gk ? gk[k0 + kk] : 1.0f) * qs : 0.f; } }
    __syncthreads();
    { const int n = tid >> 3, ch = tid & 7; const LAS float* s = tile + (ch * 8) * 65 + n;
      u32x4 o; o.x = pk_bf16(s[0], s[65]); o.y = pk_bf16(s[2 * 65], s[3 * 65]); o.z = pk_bf16(s[4 * 65], s[5 * 65]); o.w = pk_bf16(s[6 * 65], s[7 * 65]);
      *(u32x4*)(Wt + (size_t)(n0 + n) * K + k0 + ch * 8) = o; }
    __syncthreads();
}

__device__ __forceinline__ void rms_row(const float* xrow, const float* g, bf16_t* ob, float* of, unsigned long long* ssrow, int lane) {
    f32x4 v[4]; float s = 0.f;
#pragma unroll
    for (int j = 0; j < 4; ++j) { v[j] = *(const f32x4*)(xrow + 4 * lane + 256 * j); s += (v[j][0] * v[j][0] + v[j][1] * v[j][1]) + (v[j][2] * v[j][2] + v[j][3] * v[j][3]); }
    s = wave_sum(s);
    const float r = ob ? 1.0f : 1.0f / sqrtf(s * (1.0f / DM) + RMS_EPS);
    if (ob && lane == 0) *ssrow = (unsigned long long)(s * SS_SCALE);
#pragma unroll
    for (int j = 0; j < 4; ++j) { const f32x4 gg = ob ? (f32x4){1.f, 1.f, 1.f, 1.f} : *(const f32x4*)(g + 4 * lane + 256 * j); f32x4 y;
        y[0] = v[j][0] * r * gg[0]; y[1] = v[j][1] * r * gg[1]; y[2] = v[j][2] * r * gg[2]; y[3] = v[j][3] * r * gg[3];
        if (ob) { u32x2 w; w.x = pk_bf16(y[0], y[1]); w.y = pk_bf16(y[2], y[3]); *(u32x2*)(ob + 4 * lane + 256 * j) = w; }
        else *(f32x4*)(of + 4 * lane + 256 * j) = y; }
}

__device__ __forceinline__ void phase_prologue(const Params& P, LAS unsigned char* lds) {
    const int tid = otid(), lane = tid & 63, wave = tid >> 6;
    unsigned char* ws = P.ws;
    LAS float* tile = (LAS float*)lds;
    constexpr int I_WIN = DEPTH * 16 * 68, I_WOUT = DEPTH * 16 * 16, I_WG = I_WOUT, I_WP = DEPTH * 4 * 16, I_W1 = DEPTH * 2 * 32, I_W2 = DEPTH * 2;
    constexpr int NIT = I_WIN + I_WOUT + I_WG + I_WP + I_W1 + I_W2;
    for (int half_ = 0; half_ < 2; ++half_) {
    if ((half_ == 0) != ((blockIdx.x & 1) != 0)) {
    for (int it = blockIdx.x; it < NIT; it += gridDim.x) {
        int r = it;
        if (r < I_WIN) { const int L = r / (16 * 68), q = r % (16 * 68), kb = q / 68, nb = q % 68;
            transpose_item(P.w_in + (size_t)L * DM * DIN, DIN, DIN, 1, (bf16_t*)(ws + WS_WIN) + (size_t)L * NU * DM, DM, nb * 64, kb * 64, tile, P.norm_mix + (size_t)L * DM); continue; } r -= I_WIN;
        if (r < I_WOUT) { const int L = r / 256, q = r % 256, kb = q / 16, nb = q % 16;
            transpose_item(P.w_out + (size_t)L * DM * DM, DM, DM, 0, (bf16_t*)(ws + WS_WOUT) + (size_t)L * DM * DM, DM, nb * 64, kb * 64, tile); continue; } r -= I_WOUT;
        if (r < I_WG) { const int L = r / 256, q = r % 256, kb = q / 16, nb = q % 16;
            transpose_item(P.w_gate + (size_t)L * DM * DM, DM, DM, 0, (bf16_t*)(ws + WS_WGATE) + (size_t)L * DM * DM, DM, nb * 64, kb * 64, tile); continue; } r -= I_WG;
        if (r < I_WP) { const int L = r / 64, q = r % 64, kb = q / 16, nb = q % 16;
            transpose_item(P.w_proj + (size_t)L * PLE * DM, DM, DM, 0, (bf16_t*)(ws + WS_WPROJ) + (size_t)L * DM * PLE, PLE, nb * 64, kb * 64, tile); continue; } r -= I_WP;
        if (r < I_W1) { const int mtx = r / 32, kb = r % 32;
            transpose_item(P.cmp_w1 + (size_t)mtx * 2048 * 64, 64, 64, 0, (bf16_t*)(ws + WS_W1T) + (size_t)mtx * 64 * 2048, 2048, 0, kb * 64, tile); continue; } r -= I_W1;
        { const int mtx = r;
            transpose_item(P.cmp_w2 + (size_t)mtx * 64 * 64, 64, 64, 0, (bf16_t*)(ws + WS_W2T) + (size_t)mtx * 64 * 64, 64, 0, 0, tile); }
    }
    } else {
    { const int gwc = blockIdx.x * 8 + wave;
      if (gwc < DEPTH * 2 * 32) { const int mtx = gwc >> 5, ch = gwc & 31;
          const float* pe = P.cmp_pe + (size_t)mtx * 2048 + ch * 64; const float* w1 = P.cmp_w1 + (size_t)mtx * 2048 * 64 + (size_t)ch * 64 * 64 + lane; float sacc = 0.f;
#pragma unroll 8
          for (int k = 0; k < 64; ++k) sacc += pe[k] * w1[(size_t)k * 64];
          ((float*)(ws + WS_C1 + 32768))[gwc * 64 + lane] = sacc; } }
    { const int gw = blockIdx.x * 8 + wave, ngw = gridDim.x * 8;
      for (int m = gw; m < MTOK; m += ngw) rms_row(P.x + (size_t)m * DM, P.norm_mix, (bf16_t*)(ws + WS_H2B) + (size_t)m * DM, nullptr, (unsigned long long*)(ws + WS_SS) + m, lane);
    }
    { const size_t n8 = (size_t)DEPTH * MTOK * PLE / 8; bf16_t* pb = (bf16_t*)(ws + WS_PB);
      for (size_t i = (size_t)blockIdx.x * 512 + tid; i < n8; i += (size_t)gridDim.x * 512) {
          const f32x4 a = *(const f32x4*)(P.p + i * 8), b = *(const f32x4*)(P.p + i * 8 + 4);
          u32x4 w; w.x = pk_bf16(a[0], a[1]); w.y = pk_bf16(a[2], a[3]); w.z = pk_bf16(b[0], b[1]); w.w = pk_bf16(b[2], b[3]);
          *(u32x4*)(pb + i * 8) = w; } }
    }
    }
}

__device__ __forceinline__ void compress_task(const Params& P, int layer, int task, int quarter, LAS float* part, int wave, int lane) {
    const int fr = lane & 15, fq = lane >> 4;
    unsigned char* ws = P.ws;
    const int nt = task & 31, g = (task >> 5) & 1, b = (task >> 6) & 3, kv = task >> 8;
    const bf16_t* U = (const bf16_t*)(ws + WS_U);
    const int mtx = layer * 2 + kv;
    const bf16_t* w1t = (const bf16_t*)(ws + WS_W1T) + (size_t)mtx * 64 * 2048;
    const bf16_t* w2t = (const bf16_t*)(ws + WS_W2T) + (size_t)mtx * 64 * 64;
    const float* c1 = (const float*)(ws + WS_C1) + mtx * 64;
    const int n = nt * 16 + fr;
    const int col = (kv ? C_VC : C_KC) + g * 64;
    f32x4 acc[4];
#pragma unroll
    for (int h = 0; h < 4; ++h) acc[h] = (f32x4){0.f, 0.f, 0.f, 0.f};
    const bf16_t* arow = w1t + (size_t)fr * 2048 + fq * 8;
#pragma unroll 4
    for (int kk = quarter * 16; kk < quarter * 16 + 16; ++kk) {
        const int l = kk >> 1, e0 = (kk & 1) * 32 + fq * 8;
        int t = 16 * n + l; t = t < SEQ ? t : SEQ - 1;
        const bf16x8 bfrag = *(const bf16x8*)(U + (size_t)(b * SEQ + t) * NU + col + e0);
#pragma unroll
        for (int h = 0; h < 4; ++h) { const bf16x8 afrag = *(const bf16x8*)(arow + (size_t)h * 16 * 2048 + kk * 32);
            acc[h] = __builtin_amdgcn_mfma_f32_16x16x32_bf16(afrag, bfrag, acc[h], 0, 0, 0); }
    }
#pragma unroll
    for (int h = 0; h < 4; ++h)
#pragma unroll
        for (int j = 0; j < 4; ++j) part[(wave * 16 + h * 4 + j) * 64 + lane] = acc[h][j];
    __syncthreads();
    if (quarter == 0) {
#pragma unroll
    for (int h = 0; h < 4; ++h)
#pragma unroll
        for (int j = 0; j < 4; ++j) acc[h][j] = (part[((wave + 0) * 16 + h * 4 + j) * 64 + lane] + part[((wave + 1) * 16 + h * 4 + j) * 64 + lane]) + (part[((wave + 2) * 16 + h * 4 + j) * 64 + lane] + part[((wave + 3) * 16 + h * 4 + j) * 64 + lane]);
    bf16x8 hb[2];
#pragma unroll
    for (int s = 0; s < 2; ++s) { float v[8];
#pragma unroll
        for (int i = 0; i < 8; ++i) { const int h = 2 * s + (i >> 2), j = i & 3; v[i] = siluf_(acc[h][j] + c1[h * 16 + fq * 4 + j]); }
        u32x4 w; w.x = pk_bf16(v[0], v[1]); w.y = pk_bf16(v[2], v[3]); w.z = pk_bf16(v[4], v[5]); w.w = pk_bf16(v[6], v[7]);
        hb[s] = __builtin_bit_cast(bf16x8, w); }
    bf16_t* outp = (bf16_t*)(ws + (kv ? WS_VC : WS_KC)) + ((size_t)(b * NCMP_P + n) * 2 + g) * 64;
#pragma unroll
    for (int ot = 0; ot < 4; ++ot) { f32x4 o = (f32x4){0.f, 0.f, 0.f, 0.f};
#pragma unroll
        for (int s = 0; s < 2; ++s) { const bf16_t* wp = w2t + (size_t)(ot * 16 + fr) * 64 + 32 * s + fq * 4;
            const u32x2 a0 = *(const u32x2*)wp, a1 = *(const u32x2*)(wp + 16); u32x4 aw; aw.x = a0.x; aw.y = a0.y; aw.z = a1.x; aw.w = a1.y;
            o = __builtin_amdgcn_mfma_f32_16x16x32_bf16(__builtin_bit_cast(bf16x8, aw), hb[s], o, 0, 0, 0); }
        u32x2 w; w.x = pk_bf16(o[0], o[1]); w.y = pk_bf16(o[2], o[3]); if (n >= NCMP) { w.x = 0u; w.y = 0u; }
        *(u32x2*)(outp + ot * 16 + fq * 4) = w; }
    }
    __syncthreads();
}


__device__ __forceinline__ void gates_task(const Params& P, int layer, const bf16_t* Asrc, int task, int lane) {
    const int fr = lane & 15, fq = lane >> 4;
    unsigned char* ws = P.ws;
    const bf16_t* XN = Asrc + (size_t)(task * 16 + fr) * DM + fq * 8;
    const bf16_t* W = (const bf16_t*)(ws + WS_WIN) + (size_t)layer * NU * DM + (size_t)(C_NG + fr) * DM + fq * 8;
    f32x4 a0 = (f32x4){0.f, 0.f, 0.f, 0.f}, a1 = a0;
#pragma unroll 8
    for (int kk = 0; kk < 32; ++kk) { const bf16x8 af = *(const bf16x8*)(XN + kk * 32), b0 = *(const bf16x8*)(W + kk * 32), b1 = *(const bf16x8*)(W + (size_t)16 * DM + kk * 32);
        a0 = __builtin_amdgcn_mfma_f32_16x16x32_bf16(af, b0, a0, 0, 0, 0); a1 = __builtin_amdgcn_mfma_f32_16x16x32_bf16(af, b1, a1, 0, 0, 0); }
    bf16_t* U = (bf16_t*)(ws + WS_U) + (size_t)(task * 16 + fq * 4) * NU + C_NG; const unsigned long long* ss = (const unsigned long long*)(ws + WS_SS) + task * 16 + fq * 4;
#pragma unroll
    for (int j = 0; j < 4; ++j) { const float rs = 1.0f / sqrtf((float)ss[j] * SS_INV + RMS_EPS);
        U[(size_t)j * NU + fr] = (bf16_t)(pk_bf16(a0[j] * rs, 0.f) & 0xffffu); if (fr < 2) U[(size_t)j * NU + 16 + fr] = (bf16_t)(pk_bf16(a1[j] * rs, 0.f) & 0xffffu); }
}
#ifndef REP_SUB
#define REP_SUB 0
#endif
#ifndef PROBE_DUP
#define PROBE_DUP 0
#endif
#ifndef NSA_DUP
#define NSA_DUP 0
#endif
constexpr int KPITCH = 144;
constexpr int LDS_KVBUF = 18432;
constexpr int LDS_IMP = 2 * LDS_KVBUF, LDS_SEL = LDS_IMP + 128 * 129 * 4, LDS_ATT_END = LDS_SEL + 2048, LDS_STASH = LDS_IMP;
constexpr float MREF0 = -1e20f;
constexpr float THR = 8.0f;
typedef short v4i16_t __attribute__((ext_vector_type(4)));
__device__ __forceinline__ float max3f(float a, float b, float c) { return __builtin_fmaxf(__builtin_fmaxf(a, b), c); }

template <int NH, int MODE, bool MASKED>
__device__ __forceinline__ void attn_half(f32x4 (&o)[NH][4], f32x4 (&negm)[NH], float (&mrow)[NH], float (&lrow)[NH], const bf16x8 (&qf)[NH][2],
                                          const LAS unsigned char* Ks, const LAS unsigned char* Vs, int kb, int k0, bool en, int lo_q, int hi_q,
                                          LAS float* imp_row, float& carry, int lane) {
    const int fr = lane & 15, fq = lane >> 4;
    const bool lane_any = en && (!MASKED || ((k0 + 31 >= lo_q) && (k0 <= hi_q)));
    if (!__any(lane_any)) { carry = 0.f; return; }
    const bool interior = !MASKED || (__all(!en || ((k0 >= lo_q) && (k0 + 31 <= hi_q))) != 0);
    f32x4 s[NH][2];
    bf16x8 kf[2][2];
#pragma unroll
    for (int kt = 0; kt < 2; ++kt)
#pragma unroll
        for (int ks = 0; ks < 2; ++ks) kf[kt][ks] = *(const LAS bf16x8*)(Ks + (kb + kt * 16 + fr) * KPITCH + ks * 64 + fq * 16);
#pragma unroll
    for (int h = 0; h < NH; ++h) { f32x4 cin = negm[h]; if (!en) cin = (f32x4){NEGBIG, NEGBIG, NEGBIG, NEGBIG};
#pragma unroll
        for (int kt = 0; kt < 2; ++kt) { s[h][kt] = __builtin_amdgcn_mfma_f32_16x16x32_bf16(kf[kt][0], qf[h][0], cin, 0, 0, 0); s[h][kt] = __builtin_amdgcn_mfma_f32_16x16x32_bf16(kf[kt][1], qf[h][1], s[h][kt], 0, 0, 0); } }
    bool val[8];
#pragma unroll
    for (int i = 0; i < 8; ++i) { if (MASKED) { const int key = k0 + (i >> 2) * 16 + fq * 4 + (i & 3); val[i] = en && (interior || ((key >= lo_q) && (key <= hi_q))); } else val[i] = en; }
    bf16x8 pf[NH]; float psum[8];
#pragma unroll
    for (int i = 0; i < 8; ++i) psum[i] = 0.f;
#pragma unroll
    for (int h = 0; h < NH; ++h) {
        float p[8];
        if (MODE == 2) {
#pragma unroll
            for (int i = 0; i < 8; ++i) { p[i] = val[i] ? fexp2(s[h][i >> 2][i & 3]) * lrow[h] : 0.f; psum[i] += p[i]; }
        } else {
            float t[8];
            if (interior) {
#pragma unroll
                for (int i = 0; i < 8; ++i) t[i] = s[h][i >> 2][i & 3];
            } else {
#pragma unroll
                for (int i = 0; i < 8; ++i) t[i] = val[i] ? s[h][i >> 2][i & 3] : NEGBIG;
            }
            const float lmax = __builtin_fmaxf(max3f(t[0], t[1], t[2]), max3f(max3f(t[3], t[4], t[5]), t[6], t[7]));
            if (__any(lmax > THR)) {
                float xs[8];
#pragma unroll
                for (int kt = 0; kt < 2; ++kt) { f32x4 raw = __builtin_amdgcn_mfma_f32_16x16x32_bf16(kf[kt][0], qf[h][0], (f32x4){0.f, 0.f, 0.f, 0.f}, 0, 0, 0); raw = __builtin_amdgcn_mfma_f32_16x16x32_bf16(kf[kt][1], qf[h][1], raw, 0, 0, 0);
#pragma unroll
                    for (int j = 0; j < 4; ++j) xs[kt * 4 + j] = val[kt * 4 + j] ? raw[j] : NEGBIG; }
                float mx = __builtin_fmaxf(max3f(xs[0], xs[1], xs[2]), max3f(max3f(xs[3], xs[4], xs[5]), xs[6], xs[7]));
                mx = __builtin_fmaxf(mx, __shfl_xor(mx, 16)); mx = __builtin_fmaxf(mx, __shfl_xor(mx, 32));
                const float mnew = __builtin_fmaxf(mrow[h], mx); const float alpha = fexp2(mrow[h] - mnew); mrow[h] = mnew; negm[h] = (f32x4){-mnew, -mnew, -mnew, -mnew};
                lrow[h] *= alpha;
                if (MODE == 0) {
#pragma unroll
                    for (int dt = 0; dt < 4; ++dt) o[h][dt] = o[h][dt] * alpha;
                }
#pragma unroll
                for (int i = 0; i < 8; ++i) t[i] = xs[i] - mnew;
            }
#pragma unroll
            for (int i = 0; i < 8; ++i) p[i] = fexp2(t[i]);
            lrow[h] += ((p[0] + p[1]) + (p[2] + p[3])) + ((p[4] + p[5]) + (p[6] + p[7]));
        }
        if (MODE != 1) { u32x4 w; w.x = pk_bf16(p[0], p[1]); w.y = pk_bf16(p[2], p[3]); w.z = pk_bf16(p[4], p[5]); w.w = pk_bf16(p[6], p[7]); pf[h] = __builtin_bit_cast(bf16x8, w); }
    }
    if (MODE != 1) {
#pragma unroll
        for (int dt = 0; dt < 4; ++dt) { const LAS unsigned char* vp = Vs + (kb + fq * 4 + (fr >> 2)) * KPITCH + dt * 32 + (fr & 3) * 8;
            const v4i16_t a0 = __builtin_amdgcn_ds_read_tr16_b64_v4i16((LAS v4i16_t*)vp), a1 = __builtin_amdgcn_ds_read_tr16_b64_v4i16((LAS v4i16_t*)(vp + 16 * KPITCH));
            const bf16x8 vf = __builtin_shufflevector(a0, a1, 0, 1, 2, 3, 4, 5, 6, 7);
#pragma unroll
            for (int h = 0; h < NH; ++h) o[h][dt] = __builtin_amdgcn_mfma_f32_16x16x32_bf16(vf, pf[h], o[h][dt], 0, 0, 0); }
    }
    if (MODE == 2) {
        const int S0 = k0 >> 2;
        const float up3 = __shfl_up(psum[3], 16), up7 = __shfl_up(psum[7], 16), x3 = __shfl(psum[3], (lane & 15) + 48), x7 = __shfl(psum[7], (lane & 15) + 48);
        const float a0 = (psum[0] + psum[1]) + (psum[2] + psum[3]) + (fq > 0 ? up3 : carry);
        const float a1 = (psum[4] + psum[5]) + (psum[6] + psum[7]) + (fq > 0 ? up7 : x3);
        carry = x7;
        imp_row[S0 + fq] += a0;
        imp_row[S0 + 4 + fq] += a1;
    }
}

template <int NH, int MODE, bool USE_SEL>
__device__ __forceinline__ void attn_pass(f32x4 (&o)[NH][4], float (&mrow)[NH], float (&lrow)[NH], const bf16x8 (&qf)[NH][2],
                                          const bf16_t* Kg, const bf16_t* Vg, size_t rowstride, int kclamp_hi, int tile_lo, int tile_hi, int mid_lo, int mid_hi,
                                          int lo_q, int hi_q, unsigned s0, unsigned s1, unsigned s2, unsigned s3,
                                          LAS unsigned char* lds, LAS float* imp_row) {
    const int tid = otid(), lane = tid & 63;
    const int skey = tid >> 3, sch = tid & 7;
    if (tile_lo >= tile_hi) return;
    u32x4 kr, vr, kr2, vr2; float carry = 0.f;
    f32x4 negm[NH];
#pragma unroll
    for (int h = 0; h < NH; ++h) negm[h] = (f32x4){-mrow[h], -mrow[h], -mrow[h], -mrow[h]};
#define ATT_GLOAD(tl, KR, VR) do { int key_ = (tl) * 64 + skey; key_ = key_ < kclamp_hi ? key_ : kclamp_hi; key_ = key_ > 0 ? key_ : 0; const size_t off_ = (size_t)key_ * rowstride + sch * 8; \
        KR = *(const u32x4*)(Kg + off_); if (MODE != 1) VR = *(const u32x4*)(Vg + off_); } while (0)
#define ATT_STORE(bufp) do { *(LAS u32x4*)((bufp) + skey * KPITCH + sch * 16) = kr; if (MODE != 1) *(LAS u32x4*)((bufp) + 9216 + skey * KPITCH + sch * 16) = vr; } while (0)
    ATT_GLOAD(tile_lo, kr, vr);
    __syncthreads();
    ATT_STORE(lds);
    constexpr bool DEEP = (MODE == 0);
    if (DEEP && tile_lo + 1 < tile_hi) ATT_GLOAD(tile_lo + 1, kr, vr);
    __syncthreads();
#define ATT_TILE_LOOP(MASKED_, END_) \
    for (; tile < (END_); ++tile) { \
        LAS unsigned char* Ks = lds + ((tile - tile_lo) & 1) * LDS_KVBUF; LAS unsigned char* Vs = Ks + 9216; \
        LAS unsigned char* nxt = lds + (((tile - tile_lo) & 1) ^ 1) * LDS_KVBUF; \
        if (DEEP) { if (tile + 2 < tile_hi) ATT_GLOAD(tile + 2, kr2, vr2); } else { if (tile + 1 < tile_hi) ATT_GLOAD(tile + 1, kr, vr); } \
        bool en = true; \
        if (USE_SEL) { const unsigned w = tile < 32 ? s0 : (tile < 64 ? s1 : (tile < 96 ? s2 : s3)); en = ((w >> (tile & 31)) & 1u) != 0u; } \
        attn_half<NH, MODE, MASKED_>(o, negm, mrow, lrow, qf, Ks, Vs, 0, tile * 64, en, lo_q, hi_q, imp_row, carry, lane); \
        attn_half<NH, MODE, MASKED_>(o, negm, mrow, lrow, qf, Ks, Vs, 32, tile * 64 + 32, en, lo_q, hi_q, imp_row, carry, lane); \
        if (tile + 1 < tile_hi) ATT_STORE(nxt); \
        if (DEEP) { kr = kr2; vr = vr2; } \
        __syncthreads(); \
    }
    int tile = tile_lo;
    { const int e1 = mid_lo < tile_hi ? mid_lo : tile_hi; ATT_TILE_LOOP(true, e1) }
    { const int e2 = mid_hi < tile_hi ? mid_hi : tile_hi; ATT_TILE_LOOP(false, e2) }
    ATT_TILE_LOOP(true, tile_hi)
#undef ATT_TILE_LOOP
#undef ATT_GLOAD
#undef ATT_STORE
}

__device__ __forceinline__ void dilated_unit(const Params& P, int u, LAS unsigned char* lds) {
    const int tid = otid(), lane = tid & 63, wave = tid >> 6, fr = lane & 15, fq = lane >> 4;
    unsigned char* ws = P.ws; const bf16_t* U = (const bf16_t*)(ws + WS_U);
    const int b = u / 384, rem = u % 384, gi = rem >> 7, rem2 = rem & 127, h2 = rem2 >> 6, idx = rem2 & 63;
    const int dil = gi == 0 ? 1 : (gi == 1 ? 4 : 16), nbk = 64 / dil, r = idx / nbk, blk = idx % nbk, L = SEQ / dil;
    const int hc = gi * 128 + h2 * 64;
    const int m = blk * 128 + wave * 16 + fr; const size_t row = (size_t)b * SEQ + (size_t)m * dil + r;
    bf16x8 qf[1][2];
#pragma unroll
    for (int ks = 0; ks < 2; ++ks) qf[0][ks] = *(const bf16x8*)(U + row * NU + C_DQ + hc + ks * 32 + fq * 8);
    f32x4 o[1][4]; float mr[1] = {MREF0}, lr[1] = {0.f};
#pragma unroll
    for (int dt = 0; dt < 4; ++dt) o[0][dt] = (f32x4){0.f, 0.f, 0.f, 0.f};
    const bf16_t* Kg = U + ((size_t)b * SEQ + r) * NU + C_DK + hc; const bf16_t* Vg = U + ((size_t)b * SEQ + r) * NU + C_DV + hc;
    const int tlo = blk >= 1 ? 2 * blk - 2 : 0, thi = 2 * blk + 2;
    attn_pass<1, 0, false>(o, mr, lr, qf, Kg, Vg, (size_t)dil * NU, L - 1, tlo, thi, 0, 0, m - 128, m, 0u, 0u, 0u, 0u, lds, nullptr);
    float l = lr[0]; l += __shfl_xor(l, 16); l += __shfl_xor(l, 32);
    const float inv = frcp(fmaxf(l, 1e-30f));
    bf16_t* od = (bf16_t*)(ws + WS_OD) + row * 384 + hc;
#pragma unroll
    for (int dt = 0; dt < 4; ++dt) { u32x2 w; w.x = pk_bf16(o[0][dt][0] * inv, o[0][dt][1] * inv); w.y = pk_bf16(o[0][dt][2] * inv, o[0][dt][3] * inv);
        *(u32x2*)(od + dt * 16 + fq * 4) = w; }
    if (fq == 0) ((float*)(ws + WS_LSE))[row * 8 + gi * 2 + h2] = mr[0] + __builtin_amdgcn_logf(fmaxf(l, 1e-30f));
}

__device__ __forceinline__ void conv_phase(const Params& P, int layer) {
    unsigned char* ws = P.ws; const bf16_t* U = (const bf16_t*)(ws + WS_U); bf16_t* Y = (bf16_t*)(ws + WS_XY);
    const float* cw = P.conv_w + (size_t)layer * 3 * 256; const float* cb = P.conv_b + (size_t)layer * 256;
    const size_t total = (size_t)MTOK * 32;
    for (size_t i = (size_t)blockIdx.x * 512 + otid(); i < total; i += (size_t)gridDim.x * 512) {
        const size_t row = i >> 5; const int c = (int)(i & 31) * 8; const int t = (int)(row & (SEQ - 1));
        const bf16_t* ur = U + row * NU;
        const u32x4 ab = *(const u32x4*)(ur + C_AB + c), az = *(const u32x4*)(ur + C_AZ + c);
        const u32x4 c2 = *(const u32x4*)(ur + C_AC + c), h2 = *(const u32x4*)(ur + C_AH + c);
        u32x4 c1 = (u32x4){0u, 0u, 0u, 0u}, h1 = c1, c0 = c1, h0 = c1;
        if (t >= 1) { c1 = *(const u32x4*)(ur - NU + C_AC + c); h1 = *(const u32x4*)(ur - NU + C_AH + c); }
        if (t >= 2) { c0 = *(const u32x4*)(ur - 2 * NU + C_AC + c); h0 = *(const u32x4*)(ur - 2 * NU + C_AH + c); }
        float y[8];
#pragma unroll
        for (int e = 0; e < 8; ++e) {
            const int wi = e >> 1; const bool hi = e & 1;
            const float vb = hi ? bf_hi(ab[wi]) : bf_lo(ab[wi]), vz = hi ? bf_hi(az[wi]) : bf_lo(az[wi]);
            const float p2 = (hi ? bf_hi(c2[wi]) : bf_lo(c2[wi])) * (hi ? bf_hi(h2[wi]) : bf_lo(h2[wi]));
            const float p1 = (hi ? bf_hi(c1[wi]) : bf_lo(c1[wi])) * (hi ? bf_hi(h1[wi]) : bf_lo(h1[wi]));
            const float p0 = (hi ? bf_hi(c0[wi]) : bf_lo(c0[wi])) * (hi ? bf_hi(h0[wi]) : bf_lo(h0[wi]));
            const float cv = cw[c + e] * p0 + cw[256 + c + e] * p1 + cw[512 + c + e] * p2 + cb[c + e];
            y[e] = vb * cv * siluf_(vz);
        }
        u32x4 w; w.x = pk_bf16(y[0], y[1]); w.y = pk_bf16(y[2], y[3]); w.z = pk_bf16(y[4], y[5]); w.w = pk_bf16(y[6], y[7]);
        *(u32x4*)(Y + row * DM + c) = w;
    }
}

__device__ __forceinline__ void nsa_unit(const Params& P, int layer, int b, int g, int qb, LAS unsigned char* lds) {
    const int tid = otid(), lane = tid & 63, wave = tid >> 6, fr = lane & 15, fq = lane >> 4;
    unsigned char* ws = P.ws; const bf16_t* U = (const bf16_t*)(ws + WS_U); bf16_t* Y = (bf16_t*)(ws + WS_XY);
    LAS float* IMP = (LAS float*)(lds + LDS_IMP); LAS unsigned* SEL = (LAS unsigned*)(lds + LDS_SEL);
    const int q0 = qb * 128, qloc = wave * 16 + fr, tq = q0 + qloc; const size_t row = (size_t)b * SEQ + tq;
    __syncthreads();
    for (int i = tid; i < 128 * 129; i += 512) IMP[i] = 0.f;
    bf16x8 qf[3][2];
#pragma unroll
    for (int r = 0; r < 3; ++r)
#pragma unroll
        for (int ks = 0; ks < 2; ++ks) qf[r][ks] = *(const bf16x8*)(U + row * NU + C_NQ + (3 * g + r) * 64 + ks * 32 + fq * 8);
    float gate[3][3];
#pragma unroll
    for (int r = 0; r < 3; ++r)
#pragma unroll
        for (int br = 0; br < 3; ++br) gate[r][br] = sigmoidf_(bf2f(U[row * NU + C_NG + (3 * g + r) * 3 + br]));
    f32x4 o[3][4]; float mr[3], lr[3];
    LAS unsigned* STASH = (LAS unsigned*)(lds + LDS_STASH) + tid;
    const bf16_t* KC = (const bf16_t*)(ws + WS_KC) + ((size_t)b * NCMP_P * 2 + g) * 64; const bf16_t* VC = (const bf16_t*)(ws + WS_VC) + ((size_t)b * NCMP_P * 2 + g) * 64;
    const int nmax_q = (tq - 31) >> 4;
    const int cthi = (((q0 + 127 - 31) >> 4) >> 6) + 1;
#pragma unroll
    for (int r = 0; r < 3; ++r) { mr[r] = MREF0; lr[r] = 0.f; }
    attn_pass<3, 1, false>(o, mr, lr, qf, KC, VC, 128, NCMP_P - 1, 0, cthi, 0, 0, 0, nmax_q, 0u, 0u, 0u, 0u, lds, nullptr);
#if NSA_DUP & 4
    { float mr2[3], lr2[3];
#pragma unroll
      for (int r = 0; r < 3; ++r) { mr2[r] = MREF0; lr2[r] = 0.f; }
      attn_pass<3, 1, false>(o, mr2, lr2, qf, KC, VC, 128, NCMP_P - 1, 0, cthi, 0, 0, 0, nmax_q, 0u, 0u, 0u, 0u, lds, nullptr);
#pragma unroll
      for (int r = 0; r < 3; ++r) { lr[r] = 0.5f * (lr[r] + lr2[r]); mr[r] = 0.5f * (mr[r] + mr2[r]); } }
#endif
#pragma unroll
    for (int r = 0; r < 3; ++r) { float l = lr[r]; l += __shfl_xor(l, 16); l += __shfl_xor(l, 32); lr[r] = frcp(fmaxf(l, 1e-30f));
#pragma unroll
        for (int dt = 0; dt < 4; ++dt) o[r][dt] = (f32x4){0.f, 0.f, 0.f, 0.f}; }
    attn_pass<3, 2, false>(o, mr, lr, qf, KC, VC, 128, NCMP_P - 1, 0, cthi, 0, 0, 0, nmax_q, 0u, 0u, 0u, 0u, lds, IMP + qloc * 129);
    __syncthreads();
    {
        const int q = tid >> 2, part = tid & 3; const int t = q0 + q, cur = t >> 6; unsigned m0 = 0u, m1 = 0u, m2 = 0u, m3 = 0u;
        LAS float* ir = IMP + q * 129;
        if (cur < 16) m0 = (2u << cur) - 1u;
        else {
#define SETBIT(bi) do { const int b_ = (bi); const unsigned v_ = 1u << (b_ & 31); if (b_ < 32) m0 |= v_; else if (b_ < 64) m1 |= v_; else if (b_ < 96) m2 |= v_; else m3 |= v_; } while (0)
            SETBIT(0); SETBIT(cur - 1); SETBIT(cur);
            const int sb = part ? part : 4; float vals[32];
#pragma unroll
            for (int k = 0; k < 32; ++k) { const int sk = sb + 4 * k; vals[k] = (sk <= cur - 2) ? ir[sk < 128 ? sk : 128] : -3.f; }
            for (int it = 0; it < 13; ++it) {
                float gm = max3f(vals[0], vals[1], vals[2]);
#pragma unroll
                for (int k = 3; k < 31; k += 2) gm = max3f(gm, vals[k], vals[k + 1]);
                gm = __builtin_fmaxf(gm, vals[31]);
                gm = __builtin_fmaxf(gm, __shfl_xor(gm, 1)); gm = __builtin_fmaxf(gm, __shfl_xor(gm, 2));
                int bi = 0x7fffffff;
#pragma unroll
                for (int k = 31; k >= 0; --k) bi = (vals[k] == gm) ? sb + 4 * k : bi;
                { const int o1 = __shfl_xor(bi, 1); bi = o1 < bi ? o1 : bi; const int o2 = __shfl_xor(bi, 2); bi = o2 < bi ? o2 : bi; }
                SETBIT(bi);
#pragma unroll
                for (int k = 0; k < 32; ++k) vals[k] = (sb + 4 * k == bi) ? -2.f : vals[k];
            }
#undef SETBIT
        }
        if (part == 0) { SEL[q * 4 + 0] = m0; SEL[q * 4 + 1] = m1; SEL[q * 4 + 2] = m2; SEL[q * 4 + 3] = m3; }
    }
    __syncthreads();
#pragma unroll
    for (int r = 0; r < 3; ++r)
#pragma unroll
        for (int dt = 0; dt < 4; ++dt) { const f32x4 v = o[r][dt] * gate[r][0]; STASH[((r * 4 + dt) * 2 + 0) * 512] = pk_bf16(v[0], v[1]); STASH[((r * 4 + dt) * 2 + 1) * 512] = pk_bf16(v[2], v[3]); }
    const unsigned s0 = SEL[qloc * 4 + 0], s1 = SEL[qloc * 4 + 1], s2 = SEL[qloc * 4 + 2], s3 = SEL[qloc * 4 + 3];
    const int thi = ((q0 + 127) >> 6) + 1;
#pragma unroll
    for (int r = 0; r < 3; ++r) { mr[r] = MREF0; lr[r] = 0.f;
#pragma unroll
        for (int dt = 0; dt < 4; ++dt) o[r][dt] = (f32x4){0.f, 0.f, 0.f, 0.f}; }
    attn_pass<3, 0, true>(o, mr, lr, qf, U + (size_t)b * SEQ * NU + C_KS + g * 64, U + (size_t)b * SEQ * NU + C_VS + g * 64, NU, SEQ - 1, 0, thi, 0, q0 >> 6, 0, tq, s0, s1, s2, s3, lds, nullptr);
#if NSA_DUP & 1
    { f32x4 o2[3][4]; float mr2[3], lr2[3];
#pragma unroll
      for (int r = 0; r < 3; ++r) { mr2[r] = MREF0; lr2[r] = 0.f;
#pragma unroll
          for (int dt = 0; dt < 4; ++dt) o2[r][dt] = (f32x4){0.f, 0.f, 0.f, 0.f}; }
      attn_pass<3, 0, true>(o2, mr2, lr2, qf, U + (size_t)b * SEQ * NU + C_KS + g * 64, U + (size_t)b * SEQ * NU + C_VS + g * 64, NU, SEQ - 1, 0, thi, 0, q0 >> 6, 0, tq, s0, s1, s2, s3, lds, nullptr);
#pragma unroll
      for (int r = 0; r < 3; ++r) { lr[r] = 0.5f * (lr[r] + lr2[r]);
#pragma unroll
          for (int dt = 0; dt < 4; ++dt) o[r][dt] = (o[r][dt] + o2[r][dt]) * 0.5f; } }
#endif
#pragma unroll
    for (int r = 0; r < 3; ++r) { float l = lr[r]; l += __shfl_xor(l, 16); l += __shfl_xor(l, 32); const float f = gate[r][1] * frcp(fmaxf(l, 1e-30f));
#pragma unroll
        for (int dt = 0; dt < 4; ++dt) { const unsigned w0 = STASH[((r * 4 + dt) * 2 + 0) * 512], w1 = STASH[((r * 4 + dt) * 2 + 1) * 512]; const f32x4 v = o[r][dt] * f;
            STASH[((r * 4 + dt) * 2 + 0) * 512] = pk_bf16(bf_lo(w0) + v[0], bf_hi(w0) + v[1]); STASH[((r * 4 + dt) * 2 + 1) * 512] = pk_bf16(bf_lo(w1) + v[2], bf_hi(w1) + v[3]); } }
#pragma unroll
    for (int r = 0; r < 3; ++r) { mr[r] = MREF0; lr[r] = 0.f;
#pragma unroll
        for (int dt = 0; dt < 4; ++dt) o[r][dt] = (f32x4){0.f, 0.f, 0.f, 0.f}; }
    { const int wlo = q0 >= 511 ? (q0 - 511) >> 6 : 0;
      attn_pass<3, 0, false>(o, mr, lr, qf, U + (size_t)b * SEQ * NU + C_KW + g * 64, U + (size_t)b * SEQ * NU + C_VW + g * 64, NU, SEQ - 1, wlo, thi, (q0 >> 6) >= 6 ? (q0 >> 6) - 6 : 0, q0 >> 6, tq - 511, tq, 0u, 0u, 0u, 0u, lds, nullptr); }
#if NSA_DUP & 2
    { f32x4 o2[3][4]; float mr2[3], lr2[3]; const int wlo = q0 >= 511 ? (q0 - 511) >> 6 : 0;
#pragma unroll
      for (int r = 0; r < 3; ++r) { mr2[r] = MREF0; lr2[r] = 0.f;
#pragma unroll
          for (int dt = 0; dt < 4; ++dt) o2[r][dt] = (f32x4){0.f, 0.f, 0.f, 0.f}; }
      attn_pass<3, 0, false>(o2, mr2, lr2, qf, U + (size_t)b * SEQ * NU + C_KW + g * 64, U + (size_t)b * SEQ * NU + C_VW + g * 64, NU, SEQ - 1, wlo, thi, (q0 >> 6) >= 6 ? (q0 >> 6) - 6 : 0, q0 >> 6, tq - 511, tq, 0u, 0u, 0u, 0u, lds, nullptr);
#pragma unroll
      for (int r = 0; r < 3; ++r) { lr[r] = 0.5f * (lr[r] + lr2[r]);
#pragma unroll
          for (int dt = 0; dt < 4; ++dt) o[r][dt] = (o[r][dt] + o2[r][dt]) * 0.5f; } }
#endif
#pragma unroll
    for (int r = 0; r < 3; ++r) { float l = lr[r]; l += __shfl_xor(l, 16); l += __shfl_xor(l, 32); const float f = gate[r][2] * frcp(fmaxf(l, 1e-30f));
#pragma unroll
        for (int dt = 0; dt < 4; ++dt) { const unsigned w0 = STASH[((r * 4 + dt) * 2 + 0) * 512], w1 = STASH[((r * 4 + dt) * 2 + 1) * 512]; f32x4 v = o[r][dt] * f;
            v[0] += bf_lo(w0); v[1] += bf_hi(w0); v[2] += bf_lo(w1); v[3] += bf_hi(w1); o[r][dt] = v; } }
#pragma unroll
    for (int r = 0; r < 3; ++r)
#pragma unroll
        for (int dt = 0; dt < 4; ++dt) { const int cc = (3 * g + r) * 64 + dt * 16 + fq * 4;
            const u32x2 zw = *(const u32x2*)(U + row * NU + C_NZ + cc); const f32x4 v = o[r][dt];
            u32x2 w; w.x = pk_bf16(v[0] * siluf_(bf_lo(zw.x)), v[1] * siluf_(bf_hi(zw.x))); w.y = pk_bf16(v[2] * siluf_(bf_lo(zw.y)), v[3] * siluf_(bf_hi(zw.y)));
            *(u32x2*)(Y + row * DM + 256 + cc) = w; }
    { const bf16_t* OD = (const bf16_t*)(ws + WS_OD); const float* LSE = (const float*)(ws + WS_LSE);
      float l0[6], l1[6], l2[6]; u32x4 ov[6], zv[6];
#pragma unroll
      for (int it = 0; it < 6; ++it) { const int i = tid + it * 512; const int tl = i / 24, rr = i % 24, gi = rr >> 3, ch = rr & 7; const size_t rw = (size_t)b * SEQ + q0 + tl;
          const int cc = gi * 128 + g * 64 + ch * 8;
          l0[it] = LSE[rw * 8 + 0 + g]; l1[it] = LSE[rw * 8 + 2 + g]; l2[it] = LSE[rw * 8 + 4 + g];
          ov[it] = *(const u32x4*)(OD + rw * 384 + cc); zv[it] = *(const u32x4*)(U + rw * NU + C_DZ + cc); }
#pragma unroll
      for (int it = 0; it < 6; ++it) { const int i = tid + it * 512; const int tl = i / 24, rr = i % 24, gi = rr >> 3, ch = rr & 7; const size_t rw = (size_t)b * SEQ + q0 + tl;
          const int cc = gi * 128 + g * 64 + ch * 8;
          const float mx = fmaxf(l0[it], fmaxf(l1[it], l2[it]));
          const float e0 = fexp2(l0[it] - mx), e1 = fexp2(l1[it] - mx), e2 = fexp2(l2[it] - mx); const float a = (gi == 0 ? e0 : (gi == 1 ? e1 : e2)) * frcp(e0 + e1 + e2);
          u32x4 w;
#pragma unroll
          for (int e = 0; e < 4; ++e) w[e] = pk_bf16(a * bf_lo(ov[it][e]) * siluf_(bf_lo(zv[it][e])), a * bf_hi(ov[it][e]) * siluf_(bf_hi(zv[it][e])));
          *(u32x4*)(Y + rw * DM + 640 + cc) = w; } }
}

#define XB_TMO      128
#define XB_XCNT(j)  (256  + 64 * (j))
#define XB_XSUB(j)  (1280 + 64 * (j))
#define XB_XGEN(j)  (2304 + 64 * (j))
#define XB_TOP      3328
#define XB_TOPGEN   3392
#define XCD_BAR_WORDS 3456
#define XB_SPIN_CAP (1u << 18)

__device__ __forceinline__ unsigned xb_ld(unsigned* p)              { return __hip_atomic_load(p, __ATOMIC_RELAXED, __HIP_MEMORY_SCOPE_AGENT); }
__device__ __forceinline__ unsigned xb_add(unsigned* p, unsigned v) { return __hip_atomic_fetch_add(p, v, __ATOMIC_RELAXED, __HIP_MEMORY_SCOPE_AGENT); }
__device__ __forceinline__ unsigned xb_xcc_id() { return (unsigned)__builtin_amdgcn_s_getreg((3 << 11) | 20) & 0xFu; }
#define XB_SPIN(cond, bar) do { unsigned _sp = 0; while (cond) { __builtin_amdgcn_s_sleep(1); \
    if ((++_sp & 255u) == 0u) { if (xb_ld(&(bar)[XB_TMO])) break; if (_sp > XB_SPIN_CAP) { atomicAdd(&(bar)[XB_TMO], 1u); break; } } } } while (0)

struct XcdBarrier {
    unsigned* bar; unsigned x;
    volatile LAS unsigned* st;
};

__device__ __forceinline__ XcdBarrier xcd_barrier_post(unsigned* bar, volatile LAS unsigned* st) {
    XcdBarrier b; b.bar = bar; b.x = xb_xcc_id(); b.st = st;
    if (threadIdx.x == 0) (void)xb_add(&bar[XB_XCNT(b.x)], 1u);
    return b;
}
__device__ __forceinline__ void xcd_barrier_complete(unsigned* bar, unsigned x, unsigned& nloc, unsigned& nx) {
    const unsigned G = gridDim.x * gridDim.y * gridDim.z;
    unsigned sum, cnt, mine, sp = 0u;
    for (;;) {
        sum = 0u; cnt = 0u; mine = 0u;
#pragma unroll
        for (unsigned j = 0; j < 16; ++j) { const unsigned c = xb_ld(&bar[XB_XCNT(j)]); sum += c; cnt += (c > 0u) ? 1u : 0u; mine = (j == x) ? c : mine; }
        if (sum == G) break;
        __builtin_amdgcn_s_sleep(1);
        if ((++sp & 255u) == 0u) { if (xb_ld(&bar[XB_TMO])) break; if (sp > XB_SPIN_CAP) { atomicAdd(&bar[XB_TMO], 1u); break; } }
    }
    nloc = mine > 0u ? mine : 1u; nx = cnt > 0u ? cnt : 1u;
}

__device__ __forceinline__ void xcd_barrier(const XcdBarrier& b) {
    asm volatile("s_waitcnt vmcnt(0)" ::: "memory");
    __syncthreads();
    if (threadIdx.x == 0) {
        unsigned* bar = b.bar;
        __builtin_amdgcn_s_waitcnt(0);
        unsigned nloc = b.st[0], nx = b.st[1];
        if (nloc == 0u) { xcd_barrier_complete(bar, b.x, nloc, nx); b.st[0] = nloc; b.st[1] = nx; }
        const unsigned old = xb_add(&bar[XB_XSUB(b.x)], 1u);
        const unsigned gen = old / nloc;
        if (old + 1u == (gen + 1u) * nloc) {
            __builtin_amdgcn_fence(__ATOMIC_RELEASE, "agent");
            asm volatile("s_waitcnt vmcnt(0)" ::: "memory");
            const unsigned og = xb_add(&bar[XB_TOP], 1u);
            const unsigned tg = og / nx;
            if (og + 1u == (tg + 1u) * nx) xb_add(&bar[XB_TOPGEN], 1u);
            else XB_SPIN(xb_ld(&bar[XB_TOPGEN]) == tg, bar);
            __builtin_amdgcn_fence(__ATOMIC_ACQUIRE, "agent");
            xb_add(&bar[XB_XGEN(b.x)], 1u);
            asm volatile("s_waitcnt vmcnt(0)" ::: "memory");
        } else {
            XB_SPIN(xb_ld(&bar[XB_XGEN(b.x)]) == gen, bar);
            __builtin_amdgcn_fence(__ATOMIC_ACQUIRE, "agent");
            asm volatile("s_waitcnt vmcnt(0)" ::: "memory");
        }
    }
    __syncthreads();
}


#ifndef EXTRA_SYNC
#define EXTRA_SYNC 0
#endif
#ifndef DBG_STOP
#define DBG_STOP 0
#endif
#ifndef DBG_DUMP
#define DBG_DUMP 0
#endif
#if DBG_STOP
__device__ __forceinline__ void dbg_dump(const Params& P) {
    unsigned char* ws = P.ws; const size_t total = (size_t)MTOK * DM;
    for (size_t i = (size_t)blockIdx.x * 512 + otid(); i < total; i += (size_t)gridDim.x * 512) {
        const size_t m = i >> 10; const int c = (int)(i & 1023); float v = 0.f;
        if (DBG_DUMP == 0) { const bf16_t* U = (const bf16_t*)(ws + WS_U) + m * NU; v = bf2f(U[c]) + bf2f(U[c + 1024]) + bf2f(U[c + 2048]) + bf2f(U[c + 3072]) + (c < 256 ? bf2f(U[c + 4096]) : 0.f); }
        else if (DBG_DUMP == 1) { v = bf2f(((const bf16_t*)(ws + WS_XY))[m * DM + c]); }
        else if (DBG_DUMP == 2) { v = c < 384 ? bf2f(((const bf16_t*)(ws + WS_OD))[m * 384 + c]) : (c < 390 ? ((const float*)(ws + WS_LSE))[m * 8 + (c - 384)] : (m < 4096 && c < 512 ? bf2f(((const bf16_t*)(ws + WS_KC))[m * 128 + (c - 392)]) : 0.f)); }
        else if (DBG_DUMP == 3) { v = ((const float*)(ws + WS_H1))[i]; }
        else if (DBG_DUMP == 4) { v = bf2f(((const bf16_t*)(ws + WS_PP))[i]); }
        P.out[i] = v; }
}
#endif
constexpr int LDS_BYTES = 147456;
constexpr int NPHASE = 1 + 6 * DEPTH;

__global__ void __launch_bounds__(512) hymba_fwd(Params P) {
    extern __shared__ __attribute__((aligned(16))) unsigned char lds_raw[];
    LAS unsigned char* lds = (LAS unsigned char*)lds_raw;
    unsigned char* ws = P.ws;
    volatile LAS unsigned* bst = (volatile LAS unsigned*)(lds + LDS_BYTES - 64);
    if (threadIdx.x < 2) bst[threadIdx.x] = 0u;
    __syncthreads();
    if (P.ph_hi - P.ph_lo > 1) (void)xcd_barrier_post((unsigned*)(ws + WS_BAR), bst);
    if (P.ph_hi < 0) cg::this_grid().sync();
#define GRID_SYNC() do { XcdBarrier b_; b_.bar = (unsigned*)(P.ws + WS_BAR); b_.x = xb_xcc_id(); b_.st = (volatile LAS unsigned*)(lds + LDS_BYTES - 64); xcd_barrier(b_); } while (0)
    for (int ph = P.ph_lo; ph < P.ph_hi; ++ph) {
        if (ph >= 1 && (ph - 1) % 6 == 5 && (ph - 1) / 6 + 1 < DEPTH) continue;
        if (ph > P.ph_lo) GRID_SYNC();
#if EXTRA_SYNC
        if (ph > P.ph_lo) { for (int e_ = 0; e_ < EXTRA_SYNC; ++e_) GRID_SYNC(); }
#endif
#if DBG_STOP
        if (ph == DBG_STOP) { dbg_dump(P); continue; }
#endif
        if (ph == 0) { phase_prologue(P, lds);
#if REP_SUB & 64
            GRID_SYNC(); phase_prologue(P, lds);
#endif
            continue; }
        const int layer = (ph - 1) / 6, sub = (ph - 1) % 6;
#if REP_SUB
        for (int rep = 0; rep < ((((REP_SUB & 63) >> sub) & 1) ? 2 : 1); ++rep) { if (rep) GRID_SYNC();
#endif
        const bf16_t* a1src = (const bf16_t*)(ws + WS_H2B);
        if (sub == 0) {
            if (layer == 0 && blockIdx.x == 0) { const int t_ = otid(); if (t_ < DEPTH * 2 * 64) { const float* pp_ = (const float*)(ws + WS_C1 + 32768) + (t_ >> 6) * 32 * 64 + (t_ & 63); float a_ = 0.f;
#pragma unroll 8
                for (int c_ = 0; c_ < 32; ++c_) a_ += pp_[c_ * 64];
                ((float*)(ws + WS_C1))[t_] = a_; } }
            pg8::Gemm gm{(const pg8::bf16_t*)a1src, (const pg8::bf16_t*)(ws + WS_WIN) + (size_t)layer * NU * DM, MTOK, 4096, DM};
            pg8::StaticOrder S; S.init(MTOK, 4096, (int)gridDim.x, (int)blockIdx.x);
            EpiUS E{(bf16_t*)(ws + WS_U), NU, (const unsigned long long*)(ws + WS_SS)};
            for (int gh = 0; gh < 2; ++gh) {
                if ((gh == 0) == ((blockIdx.x & 1) != 0)) { const int tid = otid(), lane = tid & 63, wave = tid >> 6;
                    for (int t = blockIdx.x * 8 + wave; t < MTOK / 16; t += gridDim.x * 8) gates_task(P, layer, a1src, t, lane);
                    __syncthreads(); }
                if (gh == 0) pg8::gemm_phase<EpiUS, pg8::StaticOrder, true, true>((PG8_LAS unsigned char*)lds, gm, S, E);
            }
        } else if (sub == 1) {
            const int tid = otid(), lane = tid & 63, wave = tid >> 6;
            for (int u = blockIdx.x; u < 256 + 1536; u += gridDim.x) {
                if (u < 256) { compress_task(P, layer, u * 2 + (wave >> 2), wave & 3, (LAS float*)lds, wave, lane);
#if REP_SUB & 128
                    compress_task(P, layer, u * 2 + (wave >> 2), wave & 3, (LAS float*)lds, wave, lane);
#endif
                } else { dilated_unit(P, u - 256, lds);
#if REP_SUB & 256
                    dilated_unit(P, u - 256, lds);
#endif
                }
            }
            conv_phase(P, layer);
#if REP_SUB & 512
            conv_phase(P, layer);
#endif
        } else if (sub == 2) {
            const int G = (int)gridDim.x, c = (int)blockIdx.x;
            for (int k = 0;; ++k) { const int ir_ = (k + 1) * G - 1 - c; int i = (k & 1) ? ((G & 7) == 0 ? ((ir_ & ~7) | (c & 7)) : ir_) : k * G + c; if (G == 256) i = (k == 0) ? 8 * (63 - (c >> 3)) + (c & 7) : c;     if (k * G >= 512) break; if (i >= 512) continue;
                const int qb = 63 - (i >> 3), bg = i & 7; nsa_unit(P, layer, bg >> 1, bg & 1, qb, lds); }
        } else if (sub == 3) {
            { unsigned long long* ss = (unsigned long long*)(ws + WS_SS); for (int i = blockIdx.x * 512 + otid(); i < MTOK; i += gridDim.x * 512) ss[i] = 0ull; }
            for (int it = 0; it < 2; ++it) {
                const bool do_pp = ((it == 0) != ((blockIdx.x & 1) != 0));
                if (do_pp) { int kple = PLE; asm volatile("" : "+s"(kple));
                  pg8::Gemm gm{(const pg8::bf16_t*)(ws + WS_PB) + (size_t)layer * MTOK * PLE, (const pg8::bf16_t*)(ws + WS_WPROJ) + (size_t)layer * DM * PLE, MTOK, DM, kple};
                  pg8::StaticOrder S; S.init(MTOK, DM, (int)gridDim.x, (int)blockIdx.x);
                  EpiU E{(bf16_t*)(ws + WS_PP), DM};
                  pg8::gemm_phase<EpiU, pg8::StaticOrder, true, true>((PG8_LAS unsigned char*)lds, gm, S, E);
                } else { pg8::Gemm gm{(const pg8::bf16_t*)(ws + WS_XY), (const pg8::bf16_t*)(ws + WS_WOUT) + (size_t)layer * DM * DM, MTOK, DM, DM};
                  pg8::StaticOrder S; S.init(MTOK, DM, (int)gridDim.x, (int)blockIdx.x);
                  EpiRes E{(const bf16_t*)(ws + WS_H2B), (bf16_t*)(ws + WS_H1B)};
                  pg8::gemm_phase<EpiRes, pg8::StaticOrder, true, true>((PG8_LAS unsigned char*)lds, gm, S, E); }
                __syncthreads();
            }
        } else if (sub == 4) {
            pg8::Gemm gm{(const pg8::bf16_t*)(ws + WS_H1B), (const pg8::bf16_t*)(ws + WS_WGATE) + (size_t)layer * DM * DM, MTOK, DM, DM};
            pg8::StaticOrder S; S.init(MTOK, DM, (int)gridDim.x, (int)blockIdx.x);
            EpiGate E{(const bf16_t*)(ws + WS_H1B), (const bf16_t*)(ws + WS_PP), (bf16_t*)(ws + WS_H2B), (unsigned long long*)(ws + WS_SS)};
            pg8::gemm_phase<EpiGate, pg8::StaticOrder, true, true>((PG8_LAS unsigned char*)lds, gm, S, E);
        } else {
            const bf16_t* hb = (const bf16_t*)(ws + WS_H2B); const unsigned long long* ss = (const unsigned long long*)(ws + WS_SS);
            const size_t n8 = (size_t)MTOK * DM / 8;
            for (size_t i = (size_t)blockIdx.x * 512 + otid(); i < n8; i += (size_t)gridDim.x * 512) {
                const size_t row = i >> 7; const int c = (int)(i & 127) * 8;
                const float rs = 1.0f / sqrtf((float)ss[row] * SS_INV + RMS_EPS);
                const u32x4 w = *(const u32x4*)(hb + i * 8); const f32x4 g0 = *(const f32x4*)(P.norm_final + c), g1 = *(const f32x4*)(P.norm_final + c + 4);
                f32x4 o0, o1; o0[0] = bf_lo(w.x) * rs * g0[0]; o0[1] = bf_hi(w.x) * rs * g0[1]; o0[2] = bf_lo(w.y) * rs * g0[2]; o0[3] = bf_hi(w.y) * rs * g0[3];
                o1[0] = bf_lo(w.z) * rs * g1[0]; o1[1] = bf_hi(w.z) * rs * g1[1]; o1[2] = bf_lo(w.w) * rs * g1[2]; o1[3] = bf_hi(w.w) * rs * g1[3];
                *(f32x4*)(P.out + i * 8) = o0; *(f32x4*)(P.out + i * 8 + 4) = o1; }
        }
#if REP_SUB
        }
#endif
    }
}

#ifndef ONE_LAUNCH
#define ONE_LAUNCH 0
#endif
extern "C" void kernel_launch(void* const* d_in, const int* in_sizes, int n_in, void* d_out, int out_size, void* d_ws, size_t ws_size, hipStream_t stream) {
    static int grid = 0;
    if (grid == 0) {
        if (n_in != 13 || out_size != MTOK * DM || ws_size < WS_END) { fprintf(stderr, "kernel_launch: unexpected shapes (n_in %d out %d ws %zu)\n", n_in, out_size, ws_size); grid = -1; return; }
        int dev = 0, cus = 0, per_cu = 0;
        hipGetDevice(&dev); hipDeviceGetAttribute(&cus, hipDeviceAttributeMultiprocessorCount, dev);
        if (hipFuncSetAttribute((const void*)hymba_fwd, hipFuncAttributeMaxDynamicSharedMemorySize, LDS_BYTES) != hipSuccess) { fprintf(stderr, "kernel_launch: hipFuncSetAttribute failed\n"); grid = -1; return; }
        if (hipOccupancyMaxActiveBlocksPerMultiprocessor(&per_cu, (const void*)hymba_fwd, 512, LDS_BYTES) != hipSuccess || per_cu < 1) { fprintf(stderr, "kernel_launch: occupancy query says %d\n", per_cu); per_cu = 1; }
        (void)hipGetLastError();
        grid = cus * 1;
    }
    if (grid < 0) return;
    Params p{};
    p.x = (const float*)d_in[0]; p.p = (const float*)d_in[1]; p.norm_mix = (const float*)d_in[2]; p.w_in = (const float*)d_in[3]; p.conv_w = (const float*)d_in[4];
    p.conv_b = (const float*)d_in[5]; p.cmp_pe = (const float*)d_in[6]; p.cmp_w1 = (const float*)d_in[7]; p.cmp_w2 = (const float*)d_in[8]; p.w_out = (const float*)d_in[9];
    p.w_gate = (const float*)d_in[10]; p.w_proj = (const float*)d_in[11]; p.norm_final = (const float*)d_in[12];
    p.out = (float*)d_out; p.ws = (unsigned char*)d_ws;
#if ONE_LAUNCH
    if (hipMemsetAsync((char*)d_ws + WS_BAR, 0, 65536, stream) != hipSuccess) { fprintf(stderr, "kernel_launch: memset of the barrier words failed\n"); return; }
    p.ph_lo = 0; p.ph_hi = NPHASE;
    void* args[] = {&p};
    hipError_t e = hipLaunchCooperativeKernel((const void*)hymba_fwd, dim3(grid), dim3(512), args, LDS_BYTES, stream);
    if (e != hipSuccess) fprintf(stderr, "cooperative launch failed: %s (grid %d)\n", hipGetErrorString(e), grid);
#else
    for (int ph = 0; ph < (DBG_STOP ? DBG_STOP + 1 : NPHASE); ++ph) { p.ph_lo = ph; p.ph_hi = ph + 1; hipLaunchKernelGGL(hymba_fwd, dim3(grid), dim3(512), LDS_BYTES, stream, p); }
#endif
}
```

```cpp
#define ONE_LAUNCH 1
#include <hip/hip_runtime.h>
#include <hip/hip_cooperative_groups.h>
#include <cstdio>
#include <cstdint>
namespace cg = cooperative_groups;
__device__ __forceinline__ int otid() { int t = threadIdx.x; asm volatile("" : "+v"(t)); return t; }
namespace pg8 {
#define PG8_LAS __attribute__((address_space(3)))
typedef unsigned short bf16_t;
typedef short bf16x8 __attribute__((ext_vector_type(8)));
typedef float f32x4 __attribute__((ext_vector_type(4)));
typedef unsigned u32x4 __attribute__((ext_vector_type(4)));
constexpr int BM = 256, BK = 64, HALF = 128, HTB = HALF * BK * 2  , STAGE_BYTES = 8 * HTB, NXCD = 8, WGM = 8;

__host__ __device__ __forceinline__ int lds_byte(int r, int c) { const int st = (r >> 4) * 2 + (c >> 5), rr = r & 15, cc = c & 31, ob = rr * 64 + cc * 2; return st * 1024 + (ob ^ (((ob >> 9) & 1) << 5)); }
__host__ __device__ __forceinline__ void stage_rc(int b, int& R, int& C) { const int st = b / 1024, sb = b % 1024, swz = sb ^ (((sb >> 9) & 1) << 5); R = (st >> 1) * 16 + swz / 64; C = (st & 1) * 32 + (swz % 64) / 2; }
__host__ __device__ __forceinline__ int perm32(int rho) { const int n = rho >> 4, i = rho & 15; return 8 * (i >> 2) + 4 * n + (i & 3); }

struct Unit { int pm, pn; };
struct Gemm { const bf16_t* A; const bf16_t* Bt; int M, N, K; };

struct StaticOrder {
    int nM, nN, nwg, G, c;
    __host__ __device__ void init(int M, int N, int G_, int c_) { nM = M / BM; nN = N / BM; nwg = nM * nN; G = G_; c = c_; }
    __host__ __device__ bool next(int i, Unit& u) const {
        const long L = (long)i * G + c; if (L >= nwg) return false;
        int wgid = (int)L; { const int q = nwg / NXCD, r = nwg % NXCD, xcd = wgid % NXCD, off = wgid / NXCD; wgid = (xcd < r ? xcd * (q + 1) : r * (q + 1) + (xcd - r) * q) + off; }
        const int nig = WGM * nN, gid = wgid / nig, fm = gid * WGM, gsz = (nM - fm) < WGM ? (nM - fm) : WGM;
        u.pm = fm + ((wgid % nig) % gsz); u.pn = (wgid % nig) / gsz; return true;
    }
    __device__ __forceinline__ void a_ready(const Unit&) const {}
    __device__ __forceinline__ void done(const Unit&) const {}
};

template <class Epi, class Sched, bool ALIGN_EPI = false, bool SP2 = false>
__device__ __forceinline__ void gemm_phase(PG8_LAS unsigned char* lds, const Gemm g, const Sched& S, const Epi& E) {
    const int tid = otid(), wid = __builtin_amdgcn_readfirstlane(tid >> 6), lane = tid & 63, wr = wid >> 2, wc = wid & 3, fr = lane & 15, fq = lane >> 4;
    const int K = g.K, nt = K / BK;
    unsigned voffA[2], voffB[2];
#pragma unroll
    for (int i = 0; i < 2; ++i) { int R, C; stage_rc(tid * 16 + i * 8192, R, C); const int Rb = Epi::PERM ? ((R & ~31) + perm32(R & 31)) : R;
        voffA[i] = (unsigned)(R * K + C) * 2u; voffB[i] = (unsigned)(Rb * K + C) * 2u; }
    const size_t kstep = (size_t)(BK * 2);
    const size_t hstep = (size_t)HALF * K * 2;
    const size_t tstep = 2 * hstep;
    const unsigned ldsw = (unsigned)wid * 1024u;
    const int aoff = lds_byte(wr * 64 + fr, fq * 8), boff = lds_byte(wc * 32 + fr, fq * 8);
#define PG8_SA(b, h) (((b) * 2 + (h)) * HTB)
#define PG8_SB(b, h) ((4 + (b) * 2 + (h)) * HTB)
#define PG8_STAGE(bufoff, gbase, voff) do { _Pragma("unroll") for (int _i = 0; _i < 2; ++_i) \
        __builtin_amdgcn_global_load_lds((const unsigned*)((const char*)(gbase) + (voff)[_i]), (PG8_LAS unsigned*)(lds + (bufoff) + ldsw + _i * 8192), 16, 0, 0); } while (0)
#define PG8_LDA(dst, b, h) do { _Pragma("unroll") for (int m = 0; m < 4; ++m) _Pragma("unroll") for (int k = 0; k < 2; ++k) dst[m][k] = *(const PG8_LAS bf16x8*)(lds + PG8_SA(b, h) + aoff + m * 2048 + k * 1024); } while (0)
#define PG8_LDB(dst, b, h) do { _Pragma("unroll") for (int n = 0; n < 2; ++n) _Pragma("unroll") for (int k = 0; k < 2; ++k) dst[n][k] = *(const PG8_LAS bf16x8*)(lds + PG8_SB(b, h) + boff + n * 2048 + k * 1024); } while (0)
#define PG8_MMA(ai, bj, At, Bt) do { __builtin_amdgcn_s_setprio(1); _Pragma("unroll") for (int m = 0; m < 4; ++m) _Pragma("unroll") for (int n = 0; n < 2; ++n) _Pragma("unroll") for (int k = 0; k < 2; ++k) \
        acc[ai][bj][m][n] = __builtin_amdgcn_mfma_f32_16x16x32_bf16(Bt[n][k], At[m][k], acc[ai][bj][m][n], 0, 0, 0); __builtin_amdgcn_s_setprio(0); } while (0)
#define PG8_WAIT_V(n) asm volatile("s_waitcnt vmcnt(" #n ")" ::: "memory")
#define PG8_WAIT_L(n) asm volatile("s_waitcnt lgkmcnt(" #n ")" ::: "memory")
#define PG8_BAR __builtin_amdgcn_s_barrier()
#define PG8_SCHED __builtin_amdgcn_sched_barrier(0)
    Unit cur, nxt; int ui = 0;
    if (!S.next(0, cur)) return;
    f32x4 acc[2][2][4][2];
#pragma unroll
    for (int a = 0; a < 2; ++a)
#pragma unroll
        for (int b = 0; b < 2; ++b)
#pragma unroll
            for (int m = 0; m < 4; ++m)
#pragma unroll
                for (int n = 0; n < 2; ++n) acc[a][b][m][n] = (f32x4){0.f, 0.f, 0.f, 0.f};
    if constexpr (Epi::INIT) E.init(acc, cur, wr, wc, fr, fq);
    bf16x8 At[4][2], B0[2][2], B1[2][2];
    const char* cA = (const char*)g.A + (size_t)cur.pm * tstep; const char* cB = (const char*)g.Bt + (size_t)cur.pn * tstep;
    S.a_ready(cur);
    if constexpr (SP2) {
        PG8_STAGE(PG8_SB(0, 0), cB, voffB); PG8_STAGE(PG8_SB(0, 1), cB + hstep, voffB); PG8_STAGE(PG8_SA(0, 0), cA, voffA); PG8_STAGE(PG8_SA(0, 1), cA + hstep, voffA);
        if (wr == 1) PG8_BAR;
        PG8_WAIT_V(2); PG8_BAR;
        PG8_STAGE(PG8_SB(1, 0), cB + kstep, voffB); PG8_STAGE(PG8_SA(1, 0), cA + kstep, voffA); PG8_STAGE(PG8_SB(1, 1), cB + hstep + kstep, voffB);
        PG8_WAIT_V(6); PG8_BAR;
    } else {
        PG8_STAGE(PG8_SB(0, 0), cB, voffB); PG8_STAGE(PG8_SA(0, 0), cA, voffA); PG8_STAGE(PG8_SB(0, 1), cB + hstep, voffB); PG8_STAGE(PG8_SA(0, 1), cA + hstep, voffA);
        if (wr == 1) PG8_BAR;
        PG8_WAIT_V(4); PG8_BAR;
        PG8_STAGE(PG8_SB(1, 0), cB + kstep, voffB); PG8_STAGE(PG8_SA(1, 0), cA + kstep, voffA); PG8_STAGE(PG8_SB(1, 1), cB + hstep + kstep, voffB);
        PG8_WAIT_V(6); PG8_BAR;
    }
    for (;;) {
        const bool has_next = S.next(ui + 1, nxt);
        const char* nA = has_next ? (const char*)g.A + (size_t)nxt.pm * tstep : cA; const char* nB = has_next ? (const char*)g.Bt + (size_t)nxt.pn * tstep : cB;
        for (int t = 0; t < nt; t += 2) {
            const bool last = (t == nt - 2);
            const char* a1 = cA + (size_t)(t + 1) * kstep;
            const char* a2 = last ? nA : cA + (size_t)(t + 2) * kstep; const char* b2 = last ? nB : cB + (size_t)(t + 2) * kstep;
            const char* a3 = a2 + kstep; const char* b3 = b2 + kstep;
            if (last && has_next) S.a_ready(nxt);
            if constexpr (SP2) {
            PG8_LDB(B0, 0, 0); PG8_LDB(B1, 0, 1); PG8_SCHED; PG8_LDA(At, 0, 0); PG8_STAGE(PG8_SA(1, 1), a1 + hstep, voffA);
            PG8_WAIT_V(8); PG8_WAIT_L(0); PG8_BAR; PG8_MMA(0, 0, At, B0); PG8_MMA(0, 1, At, B1); PG8_BAR; PG8_SCHED;
            PG8_LDA(At, 0, 1); PG8_STAGE(PG8_SB(0, 0), b2, voffB); PG8_STAGE(PG8_SB(0, 1), b2 + hstep, voffB); PG8_STAGE(PG8_SA(0, 0), a2, voffA);
            PG8_WAIT_V(8); PG8_WAIT_L(0); PG8_BAR; PG8_MMA(1, 0, At, B0); PG8_MMA(1, 1, At, B1); PG8_BAR; PG8_SCHED;
            PG8_LDB(B0, 1, 0); PG8_LDB(B1, 1, 1); PG8_SCHED; PG8_LDA(At, 1, 0); PG8_STAGE(PG8_SA(0, 1), a2 + hstep, voffA);
            PG8_WAIT_V(8); PG8_WAIT_L(0); PG8_BAR; PG8_MMA(0, 0, At, B0); PG8_MMA(0, 1, At, B1); PG8_BAR; PG8_SCHED;
            PG8_LDA(At, 1, 1); PG8_STAGE(PG8_SB(1, 0), b3, voffB); PG8_STAGE(PG8_SB(1, 1), b3 + hstep, voffB); PG8_STAGE(PG8_SA(1, 0), a3, voffA);
            PG8_WAIT_V(8); PG8_WAIT_L(0); PG8_BAR; PG8_MMA(1, 0, At, B0); PG8_MMA(1, 1, At, B1); PG8_BAR; PG8_SCHED;
            } else {
            PG8_LDB(B0, 0, 0); PG8_SCHED; PG8_LDA(At, 0, 0); PG8_STAGE(PG8_SA(1, 1), a1 + hstep, voffA);
            PG8_WAIT_L(8); PG8_BAR; PG8_WAIT_L(0); PG8_MMA(0, 0, At, B0); PG8_BAR; PG8_SCHED;
            PG8_LDB(B1, 0, 1); PG8_STAGE(PG8_SB(0, 0), b2, voffB);
            PG8_BAR; PG8_WAIT_L(0); PG8_MMA(0, 1, At, B1); PG8_BAR;
            PG8_LDA(At, 0, 1); PG8_STAGE(PG8_SA(0, 0), a2, voffA);
            PG8_BAR; PG8_WAIT_L(0); PG8_MMA(1, 0, At, B0); PG8_BAR; PG8_SCHED;
            PG8_STAGE(PG8_SB(0, 1), b2 + hstep, voffB);
            PG8_WAIT_V(6); PG8_BAR; PG8_MMA(1, 1, At, B1); PG8_BAR;
            PG8_LDB(B0, 1, 0); PG8_SCHED; PG8_LDA(At, 1, 0); PG8_STAGE(PG8_SA(0, 1), a2 + hstep, voffA);
            PG8_WAIT_L(8); PG8_BAR; PG8_WAIT_L(0); PG8_MMA(0, 0, At, B0); PG8_BAR; PG8_SCHED;
            PG8_LDB(B1, 1, 1); PG8_STAGE(PG8_SB(1, 0), b3, voffB);
            PG8_BAR; PG8_WAIT_L(0); PG8_MMA(0, 1, At, B1); PG8_BAR;
            PG8_LDA(At, 1, 1); PG8_STAGE(PG8_SA(1, 0), a3, voffA);
            PG8_BAR; PG8_WAIT_L(0); PG8_MMA(1, 0, At, B0); PG8_BAR; PG8_SCHED;
            PG8_STAGE(PG8_SB(1, 1), b3 + hstep, voffB);
            PG8_WAIT_V(6); PG8_BAR; PG8_MMA(1, 1, At, B1); PG8_BAR;
            }
        }
        if constexpr (ALIGN_EPI) { if (wr == 0) PG8_BAR; }
        if constexpr (!Epi::AFTER_DRAIN) { E(acc, cur, wr, wc, fr, fq); S.done(cur); }
        if (!has_next) break;
#pragma unroll
        for (int a = 0; a < 2; ++a)
#pragma unroll
            for (int b = 0; b < 2; ++b)
#pragma unroll
                for (int m = 0; m < 4; ++m)
#pragma unroll
                    for (int n = 0; n < 2; ++n) acc[a][b][m][n] = (f32x4){0.f, 0.f, 0.f, 0.f};
        if constexpr (Epi::INIT) E.init(acc, nxt, wr, wc, fr, fq);
        cur = nxt; cA = nA; cB = nB; ++ui;
        if constexpr (ALIGN_EPI) { if (wr == 1) PG8_BAR; }
    }
    PG8_WAIT_V(0);
    if constexpr (!ALIGN_EPI) { if (wr == 0) PG8_BAR; }
    PG8_BAR;
    if constexpr (Epi::AFTER_DRAIN) { E.fused(acc, cur, wr, wc, fr, fq, lds, wid, lane); S.done(cur); }
#undef PG8_SA
#undef PG8_SB
#undef PG8_STAGE
#undef PG8_LDA
#undef PG8_LDB
#undef PG8_MMA
#undef PG8_WAIT_V
#undef PG8_WAIT_L
#undef PG8_BAR
#undef PG8_SCHED
}
}

#define LAS __attribute__((address_space(3)))
typedef unsigned short bf16_t;
typedef short bf16x8 __attribute__((ext_vector_type(8)));
typedef float f32x4 __attribute__((ext_vector_type(4)));
typedef unsigned u32x4 __attribute__((ext_vector_type(4)));
typedef unsigned u32x2 __attribute__((ext_vector_type(2)));

constexpr int BATCH = 4, SEQ = 8192, DM = 1024, MTOK = BATCH * SEQ, PLE = 256, DEPTH = 2;
constexpr int DIN = 4114, NU = 4352;
constexpr int C_AB = 0, C_AC = 256, C_AH = 512, C_AZ = 768, C_NQ = 1024, C_KC = 1408, C_VC = 1536, C_KS = 1664, C_VS = 1792,
              C_KW = 1920, C_VW = 2048, C_NZ = 2176, C_DQ = 2560, C_DK = 2944, C_DV = 3328, C_DZ = 3712, C_NG = 4096;
constexpr int NCMP = 511, NCMP_P = 512;
constexpr float RMS_EPS = 1e-6f;
constexpr float SS_SCALE = 4294967296.0f, SS_INV = 1.0f / 4294967296.0f / 1024.0f;
constexpr float LOG2E = 1.4426950408889634f;
constexpr float SC2 = 0.125f * LOG2E;
constexpr float NEGBIG = -1e30f;

constexpr size_t MiB = 1u << 20;
constexpr size_t WS_U = 0;
constexpr size_t WS_H1 = 0;
constexpr size_t WS_H1B = 128 * MiB;
constexpr size_t WS_PP = 192 * MiB;
constexpr size_t WS_XY = 272 * MiB;
constexpr size_t WS_PB = 336 * MiB;
constexpr size_t WS_OD = 368 * MiB;
constexpr size_t WS_LSE = 392 * MiB;
constexpr size_t WS_KC = 393 * MiB;
constexpr size_t WS_VC = WS_KC + 512 * 1024;
constexpr size_t WS_C1 = 394 * MiB;
constexpr size_t WS_SS = 394 * MiB + 65536;
constexpr size_t WS_WIN = 395 * MiB;
constexpr size_t WS_WOUT = 412 * MiB;
constexpr size_t WS_WGATE = 416 * MiB;
constexpr size_t WS_WPROJ = 420 * MiB;
constexpr size_t WS_W1T = 421 * MiB;
constexpr size_t WS_W2T = 422 * MiB;
constexpr size_t WS_BAR = 423 * MiB;
constexpr size_t WS_H2B = 424 * MiB;
constexpr size_t WS_END = 488 * MiB;

struct Params {
    const float *x, *p, *norm_mix, *w_in, *conv_w, *conv_b, *cmp_pe, *cmp_w1, *cmp_w2, *w_out, *w_gate, *w_proj, *norm_final;
    float* out; unsigned char* ws; int ph_lo, ph_hi;
};

typedef float f32x2_t __attribute__((ext_vector_type(2))); typedef __bf16 bf16x2_t __attribute__((ext_vector_type(2)));
__device__ __forceinline__ unsigned pk_bf16(float lo, float hi) { const f32x2_t v = {lo, hi}; const bf16x2_t b = __builtin_convertvector(v, bf16x2_t); return __builtin_bit_cast(unsigned, b); }
__device__ __forceinline__ float bf_lo(unsigned w) { return __uint_as_float(w << 16); }
__device__ __forceinline__ float bf_hi(unsigned w) { return __uint_as_float(w & 0xffff0000u); }
__device__ __forceinline__ float bf2f(bf16_t v) { return __uint_as_float(((unsigned)v) << 16); }
__device__ __forceinline__ float fexp2(float x) { return __builtin_amdgcn_exp2f(x); }
__device__ __forceinline__ float frcp(float x) { return __builtin_amdgcn_rcpf(x); }
__device__ __forceinline__ float sigmoidf_(float x) { return frcp(1.0f + fexp2(-x * LOG2E)); }
__device__ __forceinline__ float siluf_(float x) { return x * sigmoidf_(x); }
__device__ __forceinline__ float wave_sum(float v) {
#pragma unroll
    for (int o = 1; o < 64; o <<= 1) v += __shfl_xor(v, o);
    return v;
}

struct EpiU {
    static constexpr bool PERM = true, AFTER_DRAIN = false, INIT = false;
    bf16_t* O; int ldc;
    __device__ __forceinline__ void operator()(const pg8::f32x4 (&acc)[2][2][4][2], const pg8::Unit& u, int wr, int wc, int fr, int fq) const {
        const int row0 = u.pm * 256 + wr * 64 + fr; const int col0 = u.pn * 256 + wc * 32 + 8 * fq;
#pragma unroll
        for (int ai = 0; ai < 2; ++ai)
#pragma unroll
            for (int m = 0; m < 4; ++m) { bf16_t* rowp = O + (size_t)(row0 + ai * 128 + m * 16) * ldc + col0;
#pragma unroll
                for (int bj = 0; bj < 2; ++bj) { const pg8::f32x4 v0 = acc[ai][bj][m][0], v1 = acc[ai][bj][m][1];
                    u32x4 w; w.x = pk_bf16(v0[0], v0[1]); w.y = pk_bf16(v0[2], v0[3]); w.z = pk_bf16(v1[0], v1[1]); w.w = pk_bf16(v1[2], v1[3]);
                    *(u32x4*)(rowp + bj * 128) = w; } }
    }
};
struct EpiUS {
    static constexpr bool PERM = true, AFTER_DRAIN = false, INIT = false;
    bf16_t* O; int ldc; const unsigned long long* ss;
    __device__ __forceinline__ void operator()(const pg8::f32x4 (&acc)[2][2][4][2], const pg8::Unit& u, int wr, int wc, int fr, int fq) const {
        const int row0 = u.pm * 256 + wr * 64 + fr; const int col0 = u.pn * 256 + wc * 32 + 8 * fq;
#pragma unroll
        for (int ai = 0; ai < 2; ++ai)
#pragma unroll
            for (int m = 0; m < 4; ++m) { const int row = row0 + ai * 128 + m * 16; bf16_t* rowp = O + (size_t)row * ldc + col0;
                const float rs = 1.0f / sqrtf((float)ss[row] * SS_INV + RMS_EPS);
#pragma unroll
                for (int bj = 0; bj < 2; ++bj) { const pg8::f32x4 v0 = acc[ai][bj][m][0] * rs, v1 = acc[ai][bj][m][1] * rs;
                    u32x4 w; w.x = pk_bf16(v0[0], v0[1]); w.y = pk_bf16(v0[2], v0[3]); w.z = pk_bf16(v1[0], v1[1]); w.w = pk_bf16(v1[2], v1[3]);
                    *(u32x4*)(rowp + bj * 128) = w; } }
    }
};
struct EpiRes {
    static constexpr bool PERM = true, AFTER_DRAIN = false, INIT = true;
    const bf16_t* baseb; bf16_t* outb;
    __device__ __forceinline__ void init(pg8::f32x4 (&acc)[2][2][4][2], const pg8::Unit& u, int wr, int wc, int fr, int fq) const {
        const int row0 = u.pm * 256 + wr * 64 + fr; const int col0 = u.pn * 256 + wc * 32 + 8 * fq;
#pragma unroll
        for (int ai = 0; ai < 2; ++ai)
#pragma unroll
            for (int m = 0; m < 4; ++m) { const size_t ro = (size_t)(row0 + ai * 128 + m * 16) * DM + col0;
#pragma unroll
                for (int bj = 0; bj < 2; ++bj) { const u32x4 w = *(const u32x4*)(baseb + ro + bj * 128);
                    acc[ai][bj][m][0] = (f32x4){bf_lo(w.x), bf_hi(w.x), bf_lo(w.y), bf_hi(w.y)}; acc[ai][bj][m][1] = (f32x4){bf_lo(w.z), bf_hi(w.z), bf_lo(w.w), bf_hi(w.w)}; } }
    }
    __device__ __forceinline__ void operator()(const pg8::f32x4 (&acc)[2][2][4][2], const pg8::Unit& u, int wr, int wc, int fr, int fq) const {
        const int row0 = u.pm * 256 + wr * 64 + fr; const int col0 = u.pn * 256 + wc * 32 + 8 * fq;
#pragma unroll
        for (int ai = 0; ai < 2; ++ai)
#pragma unroll
            for (int m = 0; m < 4; ++m) { const size_t ro = (size_t)(row0 + ai * 128 + m * 16) * DM + col0;
#pragma unroll
                for (int bj = 0; bj < 2; ++bj) { const f32x4 v0 = acc[ai][bj][m][0], v1 = acc[ai][bj][m][1];
                    u32x4 w; w.x = pk_bf16(v0[0], v0[1]); w.y = pk_bf16(v0[2], v0[3]); w.z = pk_bf16(v1[0], v1[1]); w.w = pk_bf16(v1[2], v1[3]);
                    *(u32x4*)(outb + ro + bj * 128) = w; } }
    }
};
struct EpiGate {
    static constexpr bool PERM = true, AFTER_DRAIN = false, INIT = false;
    const bf16_t* h1; const bf16_t* pp; bf16_t* xg; unsigned long long* ss;
    __device__ __forceinline__ void operator()(const pg8::f32x4 (&acc)[2][2][4][2], const pg8::Unit& u, int wr, int wc, int fr, int fq) const {
        const int row0 = u.pm * 256 + wr * 64 + fr; const int col0 = u.pn * 256 + wc * 32 + 8 * fq;
#pragma unroll
        for (int ai = 0; ai < 2; ++ai)
#pragma unroll
            for (int m = 0; m < 4; ++m) { const int row = row0 + ai * 128 + m * 16; const size_t ro = (size_t)row * DM + col0; float sq = 0.f;
#pragma unroll
                for (int bj = 0; bj < 2; ++bj) { const size_t off = ro + bj * 128;
                    const u32x4 hw = *(const u32x4*)(h1 + off); const u32x4 pw = *(const u32x4*)(pp + off); const f32x4 a0 = acc[ai][bj][m][0], a1 = acc[ai][bj][m][1];
                    float v[8];
                    v[0] = bf_lo(hw.x) + sigmoidf_(a0[0]) * bf_lo(pw.x); v[1] = bf_hi(hw.x) + sigmoidf_(a0[1]) * bf_hi(pw.x);
                    v[2] = bf_lo(hw.y) + sigmoidf_(a0[2]) * bf_lo(pw.y); v[3] = bf_hi(hw.y) + sigmoidf_(a0[3]) * bf_hi(pw.y);
                    v[4] = bf_lo(hw.z) + sigmoidf_(a1[0]) * bf_lo(pw.z); v[5] = bf_hi(hw.z) + sigmoidf_(a1[1]) * bf_hi(pw.z);
                    v[6] = bf_lo(hw.w) + sigmoidf_(a1[2]) * bf_lo(pw.w); v[7] = bf_hi(hw.w) + sigmoidf_(a1[3]) * bf_hi(pw.w);
                    sq += ((v[0] * v[0] + v[1] * v[1]) + (v[2] * v[2] + v[3] * v[3])) + ((v[4] * v[4] + v[5] * v[5]) + (v[6] * v[6] + v[7] * v[7]));
                    u32x4 w; w.x = pk_bf16(v[0], v[1]); w.y = pk_bf16(v[2], v[3]); w.z = pk_bf16(v[4], v[5]); w.w = pk_bf16(v[6], v[7]); *(u32x4*)(xg + off) = w; }
                sq += __shfl_xor(sq, 16); sq += __shfl_xor(sq, 32);
                if (fq == 0) atomicAdd(ss + row, (unsigned long long)(sq * SS_SCALE)); }
    }
};

__device__ __forceinline__ int win_src_col(int n) { return n < 2176 ? n : (n < 4096 ? n + 18 : (n < 4114 ? 2176 + (n - 4096) : -1)); }

__device__ __forceinline__ void transpose_item(const float* W, int ldw, int nsrc, int mode, bf16_t* Wt, int K, int n0, int k0, LAS float* tile, const float* gk = nullptr) {
    const int tid = otid();
    { const int nn = tid & 63; const int np = n0 + nn; const int src = mode ? win_src_col(np) : (np < nsrc ? np : -1);
      const float qs = (mode && ((np >= C_NQ && np < C_NQ + 384) || (np >= C_DQ && np < C_DQ + 384))) ? SC2 : 1.0f;
#pragma unroll
      for (int i = 0; i < 8; ++i) { const int kk = i * 8 + (tid >> 6); tile[kk * 65 + nn] = src >= 0 ? W[(size_t)(k0 + kk) * ldw + src] * (gk ? gk[k0 + kk] : 1.0f) * qs : 0.f; } }
    __syncthreads();
    { const int n = tid >> 3, ch = tid & 7; const LAS float* s = tile + (ch * 8) * 65 + n;
      u32x4 o; o.x = pk_bf16(s[0], s[65]); o.y = pk_bf16(s[2 * 65], s[3 * 65]); o.z = pk_bf16(s[4 * 65], s[5 * 65]); o.w = pk_bf16(s[6 * 65], s[7 * 65]);
      *(u32x4*)(Wt + (size_t)(n0 + n) * K + k0 + ch * 8) = o; }
    __syncthreads();
}

__device__ __forceinline__ void rms_row(const float* xrow, const float* g, bf16_t* ob, float* of, unsigned long long* ssrow, int lane) {
    f32x4 v[4]; float s = 0.f;
#pragma unroll
    for (int j = 0; j < 4; ++j) { v[j] = *(const f32x4*)(xrow + 4 * lane + 256 * j); s += (v[j][0] * v[j][0] + v[j][1] * v[j][1]) + (v[j][2] * v[j][2] + v[j][3] * v[j][3]); }
    s = wave_sum(s);
    const float r = ob ? 1.0f : 1.0f / sqrtf(s * (1.0f / DM) + RMS_EPS);
    if (ob && lane == 0) *ssrow = (unsigned long long)(s * SS_SCALE);
#pragma unroll
    for (int j = 0; j < 4; ++j) { const f32x4 gg = ob ? (f32x4){1.f, 1.f, 1.f, 1.f} : *(const f32x4*)(g + 4 * lane + 256 * j); f32x4 y;
        y[0] = v[j][0] * r * gg[0]; y[1] = v[j][1] * r * gg[1]; y[2] = v[j][2] * r * gg[2]; y[3] = v[j][3] * r * gg[3];
        if (ob) { u32x2 w; w.x = pk_bf16(y[0], y[1]); w.y = pk_bf16(y[2], y[3]); *(u32x2*)(ob + 4 * lane + 256 * j) = w; }
        else *(f32x4*)(of + 4 * lane + 256 * j) = y; }
}

__device__ __forceinline__ void phase_prologue(const Params& P, LAS unsigned char* lds) {
    const int tid = otid(), lane = tid & 63, wave = tid >> 6;
    unsigned char* ws = P.ws;
    LAS float* tile = (LAS float*)lds;
    constexpr int I_WIN = DEPTH * 16 * 68, I_WOUT = DEPTH * 16 * 16, I_WG = I_WOUT, I_WP = DEPTH * 4 * 16, I_W1 = DEPTH * 2 * 32, I_W2 = DEPTH * 2;
    constexpr int NIT = I_WIN + I_WOUT + I_WG + I_WP + I_W1 + I_W2;
    for (int half_ = 0; half_ < 2; ++half_) {
    if ((half_ == 0) != ((blockIdx.x & 1) != 0)) {
    for (int it = blockIdx.x; it < NIT; it += gridDim.x) {
        int r = it;
        if (r < I_WIN) { const int L = r / (16 * 68), q = r % (16 * 68), kb = q / 68, nb = q % 68;
            transpose_item(P.w_in + (size_t)L * DM * DIN, DIN, DIN, 1, (bf16_t*)(ws + WS_WIN) + (size_t)L * NU * DM, DM, nb * 64, kb * 64, tile, P.norm_mix + (size_t)L * DM); continue; } r -= I_WIN;
        if (r < I_WOUT) { const int L = r / 256, q = r % 256, kb = q / 16, nb = q % 16;
            transpose_item(P.w_out + (size_t)L * DM * DM, DM, DM, 0, (bf16_t*)(ws + WS_WOUT) + (size_t)L * DM * DM, DM, nb * 64, kb * 64, tile); continue; } r -= I_WOUT;
        if (r < I_WG) { const int L = r / 256, q = r % 256, kb = q / 16, nb = q % 16;
            transpose_item(P.w_gate + (size_t)L * DM * DM, DM, DM, 0, (bf16_t*)(ws + WS_WGATE) + (size_t)L * DM * DM, DM, nb * 64, kb * 64, tile); continue; } r -= I_WG;
        if (r < I_WP) { const int L = r / 64, q = r % 64, kb = q / 16, nb = q % 16;
            transpose_item(P.w_proj + (size_t)L * PLE * DM, DM, DM, 0, (bf16_t*)(ws + WS_WPROJ) + (size_t)L * DM * PLE, PLE, nb * 64, kb * 64, tile); continue; } r -= I_WP;
        if (r < I_W1) { const int mtx = r / 32, kb = r % 32;
            transpose_item(P.cmp_w1 + (size_t)mtx * 2048 * 64, 64, 64, 0, (bf16_t*)(ws + WS_W1T) + (size_t)mtx * 64 * 2048, 2048, 0, kb * 64, tile); continue; } r -= I_W1;
        { const int mtx = r;
            transpose_item(P.cmp_w2 + (size_t)mtx * 64 * 64, 64, 64, 0, (bf16_t*)(ws + WS_W2T) + (size_t)mtx * 64 * 64, 64, 0, 0, tile); }
    }
    } else {
    { const int gwc = blockIdx.x * 8 + wave;
      if (gwc < DEPTH * 2 * 32) { const int mtx = gwc >> 5, ch = gwc & 31;
          const float* pe = P.cmp_pe + (size_t)mtx * 2048 + ch * 64; const float* w1 = P.cmp_w1 + (size_t)mtx * 2048 * 64 + (size_t)ch * 64 * 64 + lane; float sacc = 0.f;
#pragma unroll 8
          for (int k = 0; k < 64; ++k) sacc += pe[k] * w1[(size_t)k * 64];
          ((float*)(ws + WS_C1 + 32768))[gwc * 64 + lane] = sacc; } }
    { const int gw = blockIdx.x * 8 + wave, ngw = gridDim.x * 8;
      for (int m = gw; m < MTOK; m += ngw) rms_row(P.x + (size_t)m * DM, P.norm_mix, (bf16_t*)(ws + WS_H2B) + (size_t)m * DM, nullptr, (unsigned long long*)(ws + WS_SS) + m, lane);
    }
    { const size_t n8 = (size_t)DEPTH * MTOK * PLE / 8; bf16_t* pb = (bf16_t*)(ws + WS_PB);
      for (size_t i = (size_t)blockIdx.x * 512 + tid; i < n8; i += (size_t)gridDim.x * 512) {
          const f32x4 a = *(const f32x4*)(P.p + i * 8), b = *(const f32x4*)(P.p + i * 8 + 4);
          u32x4 w; w.x = pk_bf16(a[0], a[1]); w.y = pk_bf16(a[2], a[3]); w.z = pk_bf16(b[0], b[1]); w.w = pk_bf16(b[2], b[3]);
          *(u32x4*)(pb + i * 8) = w; } }
    }
    }
}

__device__ __forceinline__ void compress_task(const Params& P, int layer, int task, int quarter, LAS float* part, int wave, int lane) {
    const int fr = lane & 15, fq = lane >> 4;
    unsigned char* ws = P.ws;
    const int nt = task & 31, g = (task >> 5) & 1, b = (task >> 6) & 3, kv = task >> 8;
    const bf16_t* U = (const bf16_t*)(ws + WS_U);
    const int mtx = layer * 2 + kv;
    const bf16_t* w1t = (const bf16_t*)(ws + WS_W1T) + (size_t)mtx * 64 * 2048;
    const bf16_t* w2t = (const bf16_t*)(ws + WS_W2T) + (size_t)mtx * 64 * 64;
    const float* c1 = (const float*)(ws + WS_C1) + mtx * 64;
    const int n = nt * 16 + fr;
    const int col = (kv ? C_VC : C_KC) + g * 64;
    f32x4 acc[4];
#pragma unroll
    for (int h = 0; h < 4; ++h) acc[h] = (f32x4){0.f, 0.f, 0.f, 0.f};
    const bf16_t* arow = w1t + (size_t)fr * 2048 + fq * 8;
#pragma unroll 4
    for (int kk = quarter * 16; kk < quarter * 16 + 16; ++kk) {
        const int l = kk >> 1, e0 = (kk & 1) * 32 + fq * 8;
        int t = 16 * n + l; t = t < SEQ ? t : SEQ - 1;
        const bf16x8 bfrag = *(const bf16x8*)(U + (size_t)(b * SEQ + t) * NU + col + e0);
#pragma unroll
        for (int h = 0; h < 4; ++h) { const bf16x8 afrag = *(const bf16x8*)(arow + (size_t)h * 16 * 2048 + kk * 32);
            acc[h] = __builtin_amdgcn_mfma_f32_16x16x32_bf16(afrag, bfrag, acc[h], 0, 0, 0); }
    }
#pragma unroll
    for (int h = 0; h < 4; ++h)
#pragma unroll
        for (int j = 0; j < 4; ++j) part[(wave * 16 + h * 4 + j) * 64 + lane] = acc[h][j];
    __syncthreads();
    if (quarter == 0) {
#pragma unroll
    for (int h = 0; h < 4; ++h)
#pragma unroll
        for (int j = 0; j < 4; ++j) acc[h][j] = (part[((wave + 0) * 16 + h * 4 + j) * 64 + lane] + part[((wave + 1) * 16 + h * 4 + j) * 64 + lane]) + (part[((wave + 2) * 16 + h * 4 + j) * 64 + lane] + part[((wave + 3) * 16 + h * 4 + j) * 64 + lane]);
    bf16x8 hb[2];
#pragma unroll
    for (int s = 0; s < 2; ++s) { float v[8];
#pragma unroll
        for (int i = 0; i < 8; ++i) { const int h = 2 * s + (i >> 2), j = i & 3; v[i] = siluf_(acc[h][j] + c1[h * 16 + fq * 4 + j]); }
        u32x4 w; w.x = pk_bf16(v[0], v[1]); w.y = pk_bf16(v[2], v[3]); w.z = pk_bf16(v[4], v[5]); w.w = pk_bf16(v[6], v[7]);
        hb[s] = __builtin_bit_cast(bf16x8, w); }
    bf16_t* outp = (bf16_t*)(ws + (kv ? WS_VC : WS_KC)) + ((size_t)(b * NCMP_P + n) * 2 + g) * 64;
#pragma unroll
    for (int ot = 0; ot < 4; ++ot) { f32x4 o = (f32x4){0.f, 0.f, 0.f, 0.f};
#pragma unroll
        for (int s = 0; s < 2; ++s) { const bf16_t* wp = w2t + (size_t)(ot * 16 + fr) * 64 + 32 * s + fq * 4;
            const u32x2 a0 = *(const u32x2*)wp, a1 = *(const u32x2*)(wp + 16); u32x4 aw; aw.x = a0.x; aw.y = a0.y; aw.z = a1.x; aw.w = a1.y;
            o = __builtin_amdgcn_mfma_f32_16x16x32_bf16(__builtin_bit_cast(bf16x8, aw), hb[s], o, 0, 0, 0); }
        u32x2 w; w.x = pk_bf16(o[0], o[1]); w.y = pk_bf16(o[2], o[3]); if (n >= NCMP) { w.x = 0u; w.y = 0u; }
        *(u32x2*)(outp + ot * 16 + fq * 4) = w; }
    }
    __syncthreads();
}


__device__ __forceinline__ void gates_task(const Params& P, int layer, const bf16_t* Asrc, int task, int lane) {
    const int fr = lane & 15, fq = lane >> 4;
    unsigned char* ws = P.ws;
    const bf16_t* XN = Asrc + (size_t)(task * 16 + fr) * DM + fq * 8;
    const bf16_t* W = (const bf16_t*)(ws + WS_WIN) + (size_t)layer * NU * DM + (size_t)(C_NG + fr) * DM + fq * 8;
    f32x4 a0 = (f32x4){0.f, 0.f, 0.f, 0.f}, a1 = a0;
#pragma unroll 8
    for (int kk = 0; kk < 32; ++kk) { const bf16x8 af = *(const bf16x8*)(XN + kk * 32), b0 = *(const bf16x8*)(W + kk * 32), b1 = *(const bf16x8*)(W + (size_t)16 * DM + kk * 32);
        a0 = __builtin_amdgcn_mfma_f32_16x16x32_bf16(af, b0, a0, 0, 0, 0); a1 = __builtin_amdgcn_mfma_f32_16x16x32_bf16(af, b1, a1, 0, 0, 0); }
    bf16_t* U = (bf16_t*)(ws + WS_U) + (size_t)(task * 16 + fq * 4) * NU + C_NG; const unsigned long long* ss = (const unsigned long long*)(ws + WS_SS) + task * 16 + fq * 4;
#pragma unroll
    for (int j = 0; j < 4; ++j) { const float rs = 1.0f / sqrtf((float)ss[j] * SS_INV + RMS_EPS);
        U[(size_t)j * NU + fr] = (bf16_t)(pk_bf16(a0[j] * rs, 0.f) & 0xffffu); if (fr < 2) U[(size_t)j * NU + 16 + fr] = (bf16_t)(pk_bf16(a1[j] * rs, 0.f) & 0xffffu); }
}
#ifndef REP_SUB
#define REP_SUB 0
#endif
#ifndef PROBE_DUP
#define PROBE_DUP 0
#endif
#ifndef NSA_DUP
#define NSA_DUP 0
#endif
constexpr int KPITCH = 144;
constexpr int LDS_KVBUF = 18432;
constexpr int LDS_IMP = 2 * LDS_KVBUF, LDS_SEL = LDS_IMP + 128 * 129 * 4, LDS_ATT_END = LDS_SEL + 2048, LDS_STASH = LDS_IMP;
constexpr float MREF0 = -1e20f;
constexpr float THR = 8.0f;
typedef short v4i16_t __attribute__((ext_vector_type(4)));
__device__ __forceinline__ float max3f(float a, float b, float c) { return __builtin_fmaxf(__builtin_fmaxf(a, b), c); }

template <int NH, int MODE, bool MASKED>
__device__ __forceinline__ void attn_half(f32x4 (&o)[NH][4], f32x4 (&negm)[NH], float (&mrow)[NH], float (&lrow)[NH], const bf16x8 (&qf)[NH][2],
                                          const LAS unsigned char* Ks, const LAS unsigned char* Vs, int kb, int k0, bool en, int lo_q, int hi_q,
                                          LAS float* imp_row, float& carry, int lane) {
    const int fr = lane & 15, fq = lane >> 4;
    const bool lane_any = en && (!MASKED || ((k0 + 31 >= lo_q) && (k0 <= hi_q)));
    if (!__any(lane_any)) { carry = 0.f; return; }
    const bool interior = !MASKED || (__all(!en || ((k0 >= lo_q) && (k0 + 31 <= hi_q))) != 0);
    f32x4 s[NH][2];
    bf16x8 kf[2][2];
#pragma unroll
    for (int kt = 0; kt < 2; ++kt)
#pragma unroll
        for (int ks = 0; ks < 2; ++ks) kf[kt][ks] = *(const LAS bf16x8*)(Ks + (kb + kt * 16 + fr) * KPITCH + ks * 64 + fq * 16);
#pragma unroll
    for (int h = 0; h < NH; ++h) { f32x4 cin = negm[h]; if (!en) cin = (f32x4){NEGBIG, NEGBIG, NEGBIG, NEGBIG};
#pragma unroll
        for (int kt = 0; kt < 2; ++kt) { s[h][kt] = __builtin_amdgcn_mfma_f32_16x16x32_bf16(kf[kt][0], qf[h][0], cin, 0, 0, 0); s[h][kt] = __builtin_amdgcn_mfma_f32_16x16x32_bf16(kf[kt][1], qf[h][1], s[h][kt], 0, 0, 0); } }
    bool val[8];
#pragma unroll
    for (int i = 0; i < 8; ++i) { if (MASKED) { const int key = k0 + (i >> 2) * 16 + fq * 4 + (i & 3); val[i] = en && (interior || ((key >= lo_q) && (key <= hi_q))); } else val[i] = en; }
    bf16x8 pf[NH]; float psum[8];
#pragma unroll
    for (int i = 0; i < 8; ++i) psum[i] = 0.f;
#pragma unroll
    for (int h = 0; h < NH; ++h) {
        float p[8];
        if (MODE == 2) {
#pragma unroll
            for (int i = 0; i < 8; ++i) { p[i] = val[i] ? fexp2(s[h][i >> 2][i & 3]) * lrow[h] : 0.f; psum[i] += p[i]; }
        } else {
            float t[8];
            if (interior) {
#pragma unroll
                for (int i = 0; i < 8; ++i) t[i] = s[h][i >> 2][i & 3];
            } else {
#pragma unroll
                for (int i = 0; i < 8; ++i) t[i] = val[i] ? s[h][i >> 2][i & 3] : NEGBIG;
            }
            const float lmax = __builtin_fmaxf(max3f(t[0], t[1], t[2]), max3f(max3f(t[3], t[4], t[5]), t[6], t[7]));
            if (__any(lmax > THR)) {
                float xs[8];
#pragma unroll
                for (int kt = 0; kt < 2; ++kt) { f32x4 raw = __builtin_amdgcn_mfma_f32_16x16x32_bf16(kf[kt][0], qf[h][0], (f32x4){0.f, 0.f, 0.f, 0.f}, 0, 0, 0); raw = __builtin_amdgcn_mfma_f32_16x16x32_bf16(kf[kt][1], qf[h][1], raw, 0, 0, 0);
#pragma unroll
                    for (int j = 0; j < 4; ++j) xs[kt * 4 + j] = val[kt * 4 + j] ? raw[j] : NEGBIG; }
                float mx = __builtin_fmaxf(max3f(xs[0], xs[1], xs[2]), max3f(max3f(xs[3], xs[4], xs[5]), xs[6], xs[7]));
                mx = __builtin_fmaxf(mx, __shfl_xor(mx, 16)); mx = __builtin_fmaxf(mx, __shfl_xor(mx, 32));
                const float mnew = __builtin_fmaxf(mrow[h], mx); const float alpha = fexp2(mrow[h] - mnew); mrow[h] = mnew; negm[h] = (f32x4){-mnew, -mnew, -mnew, -mnew};
                lrow[h] *= alpha;
                if (MODE == 0) {
#pragma unroll
                    for (int dt = 0; dt < 4; ++dt) o[h][dt] = o[h][dt] * alpha;
                }
#pragma unroll
                for (int i = 0; i < 8; ++i) t[i] = xs[i] - mnew;
            }
#pragma unroll
            for (int i = 0; i < 8; ++i) p[i] = fexp2(t[i]);
            lrow[h] += ((p[0] + p[1]) + (p[2] + p[3])) + ((p[4] + p[5]) + (p[6] + p[7]));
        }
        if (MODE != 1) { u32x4 w; w.x = pk_bf16(p[0], p[1]); w.y = pk_bf16(p[2], p[3]); w.z = pk_bf16(p[4], p[5]); w.w = pk_bf16(p[6], p[7]); pf[h] = __builtin_bit_cast(bf16x8, w); }
    }
    if (MODE != 1) {
#pragma unroll
        for (int dt = 0; dt < 4; ++dt) { const LAS unsigned char* vp = Vs + (kb + fq * 4 + (fr >> 2)) * KPITCH + dt * 32 + (fr & 3) * 8;
            const v4i16_t a0 = __builtin_amdgcn_ds_read_tr16_b64_v4i16((LAS v4i16_t*)vp), a1 = __builtin_amdgcn_ds_read_tr16_b64_v4i16((LAS v4i16_t*)(vp + 16 * KPITCH));
            const bf16x8 vf = __builtin_shufflevector(a0, a1, 0, 1, 2, 3, 4, 5, 6, 7);
#pragma unroll
            for (int h = 0; h < NH; ++h) o[h][dt] = __builtin_amdgcn_mfma_f32_16x16x32_bf16(vf, pf[h], o[h][dt], 0, 0, 0); }
    }
    if (MODE == 2) {
        const int S0 = k0 >> 2;
        const float up3 = __shfl_up(psum[3], 16), up7 = __shfl_up(psum[7], 16), x3 = __shfl(psum[3], (lane & 15) + 48), x7 = __shfl(psum[7], (lane & 15) + 48);
        const float a0 = (psum[0] + psum[1]) + (psum[2] + psum[3]) + (fq > 0 ? up3 : carry);
        const float a1 = (psum[4] + psum[5]) + (psum[6] + psum[7]) + (fq > 0 ? up7 : x3);
        carry = x7;
        imp_row[S0 + fq] += a0;
        imp_row[S0 + 4 + fq] += a1;
    }
}

template <int NH, int MODE, bool USE_SEL>
__device__ __forceinline__ void attn_pass(f32x4 (&o)[NH][4], float (&mrow)[NH], float (&lrow)[NH], const bf16x8 (&qf)[NH][2],
                                          const bf16_t* Kg, const bf16_t* Vg, size_t rowstride, int kclamp_hi, int tile_lo, int tile_hi, int mid_lo, int mid_hi,
                                          int lo_q, int hi_q, unsigned s0, unsigned s1, unsigned s2, unsigned s3,
                                          LAS unsigned char* lds, LAS float* imp_row) {
    const int tid = otid(), lane = tid & 63;
    const int skey = tid >> 3, sch = tid & 7;
    if (tile_lo >= tile_hi) return;
    u32x4 kr, vr, kr2, vr2; float carry = 0.f;
    f32x4 negm[NH];
#pragma unroll
    for (int h = 0; h < NH; ++h) negm[h] = (f32x4){-mrow[h], -mrow[h], -mrow[h], -mrow[h]};
#define ATT_GLOAD(tl, KR, VR) do { int key_ = (tl) * 64 + skey; key_ = key_ < kclamp_hi ? key_ : kclamp_hi; key_ = key_ > 0 ? key_ : 0; const size_t off_ = (size_t)key_ * rowstride + sch * 8; \
        KR = *(const u32x4*)(Kg + off_); if (MODE != 1) VR = *(const u32x4*)(Vg + off_); } while (0)
#define ATT_STORE(bufp) do { *(LAS u32x4*)((bufp) + skey * KPITCH + sch * 16) = kr; if (MODE != 1) *(LAS u32x4*)((bufp) + 9216 + skey * KPITCH + sch * 16) = vr; } while (0)
    ATT_GLOAD(tile_lo, kr, vr);
    __syncthreads();
    ATT_STORE(lds);
    constexpr bool DEEP = (MODE == 0);
    if (DEEP && tile_lo + 1 < tile_hi) ATT_GLOAD(tile_lo + 1, kr, vr);
    __syncthreads();
#define ATT_TILE_LOOP(MASKED_, END_) \
    for (; tile < (END_); ++tile) { \
        LAS unsigned char* Ks = lds + ((tile - tile_lo) & 1) * LDS_KVBUF; LAS unsigned char* Vs = Ks + 9216; \
        LAS unsigned char* nxt = lds + (((tile - tile_lo) & 1) ^ 1) * LDS_KVBUF; \
        if (DEEP) { if (tile + 2 < tile_hi) ATT_GLOAD(tile + 2, kr2, vr2); } else { if (tile + 1 < tile_hi) ATT_GLOAD(tile + 1, kr, vr); } \
        bool en = true; \
        if (USE_SEL) { const unsigned w = tile < 32 ? s0 : (tile < 64 ? s1 : (tile < 96 ? s2 : s3)); en = ((w >> (tile & 31)) & 1u) != 0u; } \
        attn_half<NH, MODE, MASKED_>(o, negm, mrow, lrow, qf, Ks, Vs, 0, tile * 64, en, lo_q, hi_q, imp_row, carry, lane); \
        attn_half<NH, MODE, MASKED_>(o, negm, mrow, lrow, qf, Ks, Vs, 32, tile * 64 + 32, en, lo_q, hi_q, imp_row, carry, lane); \
        if (tile + 1 < tile_hi) ATT_STORE(nxt); \
        if (DEEP) { kr = kr2; vr = vr2; } \
        __syncthreads(); \
    }
    int tile = tile_lo;
    { const int e1 = mid_lo < tile_hi ? mid_lo : tile_hi; ATT_TILE_LOOP(true, e1) }
    { const int e2 = mid_hi < tile_hi ? mid_hi : tile_hi; ATT_TILE_LOOP(false, e2) }
    ATT_TILE_LOOP(true, tile_hi)
#undef ATT_TILE_LOOP
#undef ATT_GLOAD
#undef ATT_STORE
}

__device__ __forceinline__ void dilated_unit(const Params& P, int u, LAS unsigned char* lds) {
    const int tid = otid(), lane = tid & 63, wave = tid >> 6, fr = lane & 15, fq = lane >> 4;
    unsigned char* ws = P.ws; const bf16_t* U = (const bf16_t*)(ws + WS_U);
    const int b = u / 384, rem = u % 384, gi = rem >> 7, rem2 = rem & 127, h2 = rem2 >> 6, idx = rem2 & 63;
    const int dil = gi == 0 ? 1 : (gi == 1 ? 4 : 16), nbk = 64 / dil, r = idx / nbk, blk = idx % nbk, L = SEQ / dil;
    const int hc = gi * 128 + h2 * 64;
    const int m = blk * 128 + wave * 16 + fr; const size_t row = (size_t)b * SEQ + (size_t)m * dil + r;
    bf16x8 qf[1][2];
#pragma unroll
    for (int ks = 0; ks < 2; ++ks) qf[0][ks] = *(const bf16x8*)(U + row * NU + C_DQ + hc + ks * 32 + fq * 8);
    f32x4 o[1][4]; float mr[1] = {MREF0}, lr[1] = {0.f};
#pragma unroll
    for (int dt = 0; dt < 4; ++dt) o[0][dt] = (f32x4){0.f, 0.f, 0.f, 0.f};
    const bf16_t* Kg = U + ((size_t)b * SEQ + r) * NU + C_DK + hc; const bf16_t* Vg = U + ((size_t)b * SEQ + r) * NU + C_DV + hc;
    const int tlo = blk >= 1 ? 2 * blk - 2 : 0, thi = 2 * blk + 2;
    attn_pass<1, 0, false>(o, mr, lr, qf, Kg, Vg, (size_t)dil * NU, L - 1, tlo, thi, 0, 0, m - 128, m, 0u, 0u, 0u, 0u, lds, nullptr);
    float l = lr[0]; l += __shfl_xor(l, 16); l += __shfl_xor(l, 32);
    const float inv = frcp(fmaxf(l, 1e-30f));
    bf16_t* od = (bf16_t*)(ws + WS_OD) + row * 384 + hc;
#pragma unroll
    for (int dt = 0; dt < 4; ++dt) { u32x2 w; w.x = pk_bf16(o[0][dt][0] * inv, o[0][dt][1] * inv); w.y = pk_bf16(o[0][dt][2] * inv, o[0][dt][3] * inv);
        *(u32x2*)(od + dt * 16 + fq * 4) = w; }
    if (fq == 0) ((float*)(ws + WS_LSE))[row * 8 + gi * 2 + h2] = mr[0] + __builtin_amdgcn_logf(fmaxf(l, 1e-30f));
}

__device__ __forceinline__ void conv_phase(const Params& P, int layer) {
    unsigned char* ws = P.ws; const bf16_t* U = (const bf16_t*)(ws + WS_U); bf16_t* Y = (bf16_t*)(ws + WS_XY);
    const float* cw = P.conv_w + (size_t)layer * 3 * 256; const float* cb = P.conv_b + (size_t)layer * 256;
    const size_t total = (size_t)MTOK * 32;
    for (size_t i = (size_t)blockIdx.x * 512 + otid(); i < total; i += (size_t)gridDim.x * 512) {
        const size_t row = i >> 5; const int c = (int)(i & 31) * 8; const int t = (int)(row & (SEQ - 1));
        const bf16_t* ur = U + row * NU;
        const u32x4 ab = *(const u32x4*)(ur + C_AB + c), az = *(const u32x4*)(ur + C_AZ + c);
        const u32x4 c2 = *(const u32x4*)(ur + C_AC + c), h2 = *(const u32x4*)(ur + C_AH + c);
        u32x4 c1 = (u32x4){0u, 0u, 0u, 0u}, h1 = c1, c0 = c1, h0 = c1;
        if (t >= 1) { c1 = *(const u32x4*)(ur - NU + C_AC + c); h1 = *(const u32x4*)(ur - NU + C_AH + c); }
        if (t >= 2) { c0 = *(const u32x4*)(ur - 2 * NU + C_AC + c); h0 = *(const u32x4*)(ur - 2 * NU + C_AH + c); }
        float y[8];
#pragma unroll
        for (int e = 0; e < 8; ++e) {
            const int wi = e >> 1; const bool hi = e & 1;
            const float vb = hi ? bf_hi(ab[wi]) : bf_lo(ab[wi]), vz = hi ? bf_hi(az[wi]) : bf_lo(az[wi]);
            const float p2 = (hi ? bf_hi(c2[wi]) : bf_lo(c2[wi])) * (hi ? bf_hi(h2[wi]) : bf_lo(h2[wi]));
            const float p1 = (hi ? bf_hi(c1[wi]) : bf_lo(c1[wi])) * (hi ? bf_hi(h1[wi]) : bf_lo(h1[wi]));
            const float p0 = (hi ? bf_hi(c0[wi]) : bf_lo(c0[wi])) * (hi ? bf_hi(h0[wi]) : bf_lo(h0[wi]));
            const float cv = cw[c + e] * p0 + cw[256 + c + e] * p1 + cw[512 + c + e] * p2 + cb[c + e];
            y[e] = vb * cv * siluf_(vz);
        }
        u32x4 w; w.x = pk_bf16(y[0], y[1]); w.y = pk_bf16(y[2], y[3]); w.z = pk_bf16(y[4], y[5]); w.w = pk_bf16(y[6], y[7]);
        *(u32x4*)(Y + row * DM + c) = w;
    }
}

__device__ __forceinline__ void nsa_unit(const Params& P, int layer, int b, int g, int qb, LAS unsigned char* lds) {
    const int tid = otid(), lane = tid & 63, wave = tid >> 6, fr = lane & 15, fq = lane >> 4;
    unsigned char* ws = P.ws; const bf16_t* U = (const bf16_t*)(ws + WS_U); bf16_t* Y = (bf16_t*)(ws + WS_XY);
    LAS float* IMP = (LAS float*)(lds + LDS_IMP); LAS unsigned* SEL = (LAS unsigned*)(lds + LDS_SEL);
    const int q0 = qb * 128, qloc = wave * 16 + fr, tq = q0 + qloc; const size_t row = (size_t)b * SEQ + tq;
    __syncthreads();
    for (int i = tid; i < 128 * 129; i += 512) IMP[i] = 0.f;
    bf16x8 qf[3][2];
#pragma unroll
    for (int r = 0; r < 3; ++r)
#pragma unroll
        for (int ks = 0; ks < 2; ++ks) qf[r][ks] = *(const bf16x8*)(U + row * NU + C_NQ + (3 * g + r) * 64 + ks * 32 + fq * 8);
    float gate[3][3];
#pragma unroll
    for (int r = 0; r < 3; ++r)
#pragma unroll
        for (int br = 0; br < 3; ++br) gate[r][br] = sigmoidf_(bf2f(U[row * NU + C_NG + (3 * g + r) * 3 + br]));
    f32x4 o[3][4]; float mr[3], lr[3];
    LAS unsigned* STASH = (LAS unsigned*)(lds + LDS_STASH) + tid;
    const bf16_t* KC = (const bf16_t*)(ws + WS_KC) + ((size_t)b * NCMP_P * 2 + g) * 64; const bf16_t* VC = (const bf16_t*)(ws + WS_VC) + ((size_t)b * NCMP_P * 2 + g) * 64;
    const int nmax_q = (tq - 31) >> 4;
    const int cthi = (((q0 + 127 - 31) >> 4) >> 6) + 1;
#pragma unroll
    for (int r = 0; r < 3; ++r) { mr[r] = MREF0; lr[r] = 0.f; }
    attn_pass<3, 1, false>(o, mr, lr, qf, KC, VC, 128, NCMP_P - 1, 0, cthi, 0, 0, 0, nmax_q, 0u, 0u, 0u, 0u, lds, nullptr);
#if NSA_DUP & 4
    { float mr2[3], lr2[3];
#pragma unroll
      for (int r = 0; r < 3; ++r) { mr2[r] = MREF0; lr2[r] = 0.f; }
      attn_pass<3, 1, false>(o, mr2, lr2, qf, KC, VC, 128, NCMP_P - 1, 0, cthi, 0, 0, 0, nmax_q, 0u, 0u, 0u, 0u, lds, nullptr);
#pragma unroll
      for (int r = 0; r < 3; ++r) { lr[r] = 0.5f * (lr[r] + lr2[r]); mr[r] = 0.5f * (mr[r] + mr2[r]); } }
#endif
#pragma unroll
    for (int r = 0; r < 3; ++r) { float l = lr[r]; l += __shfl_xor(l, 16); l += __shfl_xor(l, 32); lr[r] = frcp(fmaxf(l, 1e-30f));
#pragma unroll
        for (int dt = 0; dt < 4; ++dt) o[r][dt] = (f32x4){0.f, 0.f, 0.f, 0.f}; }
    attn_pass<3, 2, false>(o, mr, lr, qf, KC, VC, 128, NCMP_P - 1, 0, cthi, 0, 0, 0, nmax_q, 0u, 0u, 0u, 0u, lds, IMP + qloc * 129);
    __syncthreads();
    {
        const int q = tid >> 2, part = tid & 3; const int t = q0 + q, cur = t >> 6; unsigned m0 = 0u, m1 = 0u, m2 = 0u, m3 = 0u;
        LAS float* ir = IMP + q * 129;
        if (cur < 16) m0 = (2u << cur) - 1u;
        else {
#define SETBIT(bi) do { const int b_ = (bi); const unsigned v_ = 1u << (b_ & 31); if (b_ < 32) m0 |= v_; else if (b_ < 64) m1 |= v_; else if (b_ < 96) m2 |= v_; else m3 |= v_; } while (0)
            SETBIT(0); SETBIT(cur - 1); SETBIT(cur);
            const int sb = part ? part : 4; float vals[32];
#pragma unroll
            for (int k = 0; k < 32; ++k) { const int sk = sb + 4 * k; vals[k] = (sk <= cur - 2) ? ir[sk < 128 ? sk : 128] : -3.f; }
            for (int it = 0; it < 13; ++it) {
                float gm = max3f(vals[0], vals[1], vals[2]);
#pragma unroll
                for (int k = 3; k < 31; k += 2) gm = max3f(gm, vals[k], vals[k + 1]);
                gm = __builtin_fmaxf(gm, vals[31]);
                gm = __builtin_fmaxf(gm, __shfl_xor(gm, 1)); gm = __builtin_fmaxf(gm, __shfl_xor(gm, 2));
                int bi = 0x7fffffff;
#pragma unroll
                for (int k = 31; k >= 0; --k) bi = (vals[k] == gm) ? sb + 4 * k : bi;
                { const int o1 = __shfl_xor(bi, 1); bi = o1 < bi ? o1 : bi; const int o2 = __shfl_xor(bi, 2); bi = o2 < bi ? o2 : bi; }
                SETBIT(bi);
#pragma unroll
                for (int k = 0; k < 32; ++k) vals[k] = (sb + 4 * k == bi) ? -2.f : vals[k];
            }
#undef SETBIT
        }
        if (part == 0) { SEL[q * 4 + 0] = m0; SEL[q * 4 + 1] = m1; SEL[q * 4 + 2] = m2; SEL[q * 4 + 3] = m3; }
    }
    __syncthreads();
#pragma unroll
    for (int r = 0; r < 3; ++r)
#pragma unroll
        for (int dt = 0; dt < 4; ++dt) { const f32x4 v = o[r][dt] * gate[r][0]; STASH[((r * 4 + dt) * 2 + 0) * 512] = pk_bf16(v[0], v[1]); STASH[((r * 4 + dt) * 2 + 1) * 512] = pk_bf16(v[2], v[3]); }
    const unsigned s0 = SEL[qloc * 4 + 0], s1 = SEL[qloc * 4 + 1], s2 = SEL[qloc * 4 + 2], s3 = SEL[qloc * 4 + 3];
    const int thi = ((q0 + 127) >> 6) + 1;
#pragma unroll
    for (int r = 0; r < 3; ++r) { mr[r] = MREF0; lr[r] = 0.f;
#pragma unroll
        for (int dt = 0; dt < 4; ++dt) o[r][dt] = (f32x4){0.f, 0.f, 0.f, 0.f}; }
    attn_pass<3, 0, true>(o, mr, lr, qf, U + (size_t)b * SEQ * NU + C_KS + g * 64, U + (size_t)b * SEQ * NU + C_VS + g * 64, NU, SEQ - 1, 0, thi, 0, q0 >> 6, 0, tq, s0, s1, s2, s3, lds, nullptr);
#if NSA_DUP & 1
    { f32x4 o2[3][4]; float mr2[3], lr2[3];
#pragma unroll
      for (int r = 0; r < 3; ++r) { mr2[r] = MREF0; lr2[r] = 0.f;
#pragma unroll
          for (int dt = 0; dt < 4; ++dt) o2[r][dt] = (f32x4){0.f, 0.f, 0.f, 0.f}; }
      attn_pass<3, 0, true>(o2, mr2, lr2, qf, U + (size_t)b * SEQ * NU + C_KS + g * 64, U + (size_t)b * SEQ * NU + C_VS + g * 64, NU, SEQ - 1, 0, thi, 0, q0 >> 6, 0, tq, s0, s1, s2, s3, lds, nullptr);
#pragma unroll
      for (int r = 0; r < 3; ++r) { lr[r] = 0.5f * (lr[r] + lr2[r]);
#pragma unroll
          for (int dt = 0; dt < 4; ++dt) o[r][dt] = (o[r][dt] + o2[r][dt]) * 0.5f; } }
#endif
#pragma unroll
    for (int r = 0; r < 3; ++r) { float l = lr[r]; l += __shfl_xor(l, 16); l += __shfl_xor(l, 32); const float f = gate[r][1] * frcp(fmaxf(l, 1e-30f));
#pragma unroll
        for (int dt = 0; dt < 4; ++dt) { const unsigned w0 = STASH[((r * 4 + dt) * 2 + 0) * 512], w1 = STASH[((r * 4 + dt) * 2 + 1) * 512]; const f32x4 v = o[r][dt] * f;
            STASH[((r * 4 + dt) * 2 + 0) * 512] = pk_bf16(bf_lo(w0) + v[0], bf_hi(w0) + v[1]); STASH[((r * 4 + dt) * 2 + 1) * 512] = pk_bf16(bf_lo(w1) + v[2], bf_hi(w1) + v[3]); } }
#pragma unroll
    for (int r = 0; r < 3; ++r) { mr[r] = MREF0; lr[r] = 0.f;
#pragma unroll
        for (int dt = 0; dt < 4; ++dt) o[r][dt] = (f32x4){0.f, 0.f, 0.f, 0.f}; }
    { const int wlo = q0 >= 511 ? (q0 - 511) >> 6 : 0;
      attn_pass<3, 0, false>(o, mr, lr, qf, U + (size_t)b * SEQ * NU + C_KW + g * 64, U + (size_t)b * SEQ * NU + C_VW + g * 64, NU, SEQ - 1, wlo, thi, (q0 >> 6) >= 6 ? (q0 >> 6) - 6 : 0, q0 >> 6, tq - 511, tq, 0u, 0u, 0u, 0u, lds, nullptr); }
#if NSA_DUP & 2
    { f32x4 o2[3][4]; float mr2[3], lr2[3]; const int wlo = q0 >= 511 ? (q0 - 511) >> 6 : 0;
#pragma unroll
      for (int r = 0; r < 3; ++r) { mr2[r] = MREF0; lr2[r] = 0.f;
#pragma unroll
          for (int dt = 0; dt < 4; ++dt) o2[r][dt] = (f32x4){0.f, 0.f, 0.f, 0.f}; }
      attn_pass<3, 0, false>(o2, mr2, lr2, qf, U + (size_t)b * SEQ * NU + C_KW + g * 64, U + (size_t)b * SEQ * NU + C_VW + g * 64, NU, SEQ - 1, wlo, thi, (q0 >> 6) >= 6 ? (q0 >> 6) - 6 : 0, q0 >> 6, tq - 511, tq, 0u, 0u, 0u, 0u, lds, nullptr);
#pragma unroll
      for (int r = 0; r < 3; ++r) { lr[r] = 0.5f * (lr[r] + lr2[r]);
#pragma unroll
          for (int dt = 0; dt < 4; ++dt) o[r][dt] = (o[r][dt] + o2[r][dt]) * 0.5f; } }
#endif
#pragma unroll
    for (int r = 0; r < 3; ++r) { float l = lr[r]; l += __shfl_xor(l, 16); l += __shfl_xor(l, 32); const float f = gate[r][2] * frcp(fmaxf(l, 1e-30f));
#pragma unroll
        for (int dt = 0; dt < 4; ++dt) { const unsigned w0 = STASH[((r * 4 + dt) * 2 + 0) * 512], w1 = STASH[((r * 4 + dt) * 2 + 1) * 512]; f32x4 v = o[r][dt] * f;
            v[0] += bf_lo(w0); v[1] += bf_hi(w0); v[2] += bf_lo(w1); v[3] += bf_hi(w1); o[r][dt] = v; } }
#pragma unroll
    for (int r = 0; r < 3; ++r)
#pragma unroll
        for (int dt = 0; dt < 4; ++dt) { const int cc = (3 * g + r) * 64 + dt * 16 + fq * 4;
            const u32x2 zw = *(const u32x2*)(U + row * NU + C_NZ + cc); const f32x4 v = o[r][dt];
            u32x2 w; w.x = pk_bf16(v[0] * siluf_(bf_lo(zw.x)), v[1] * siluf_(bf_hi(zw.x))); w.y = pk_bf16(v[2] * siluf_(bf_lo(zw.y)), v[3] * siluf_(bf_hi(zw.y)));
            *(u32x2*)(Y + row * DM + 256 + cc) = w; }
    { const bf16_t* OD = (const bf16_t*)(ws + WS_OD); const float* LSE = (const float*)(ws + WS_LSE);
      float l0[6], l1[6], l2[6]; u32x4 ov[6], zv[6];
#pragma unroll
      for (int it = 0; it < 6; ++it) { const int i = tid + it * 512; const int tl = i / 24, rr = i % 24, gi = rr >> 3, ch = rr & 7; const size_t rw = (size_t)b * SEQ + q0 + tl;
          const int cc = gi * 128 + g * 64 + ch * 8;
          l0[it] = LSE[rw * 8 + 0 + g]; l1[it] = LSE[rw * 8 + 2 + g]; l2[it] = LSE[rw * 8 + 4 + g];
          ov[it] = *(const u32x4*)(OD + rw * 384 + cc); zv[it] = *(const u32x4*)(U + rw * NU + C_DZ + cc); }
#pragma unroll
      for (int it = 0; it < 6; ++it) { const int i = tid + it * 512; const int tl = i / 24, rr = i % 24, gi = rr >> 3, ch = rr & 7; const size_t rw = (size_t)b * SEQ + q0 + tl;
          const int cc = gi * 128 + g * 64 + ch * 8;
          const float mx = fmaxf(l0[it], fmaxf(l1[it], l2[it]));
          const float e0 = fexp2(l0[it] - mx), e1 = fexp2(l1[it] - mx), e2 = fexp2(l2[it] - mx); const float a = (gi == 0 ? e0 : (gi == 1 ? e1 : e2)) * frcp(e0 + e1 + e2);
          u32x4 w;
#pragma unroll
          for (int e = 0; e < 4; ++e) w[e] = pk_bf16(a * bf_lo(ov[it][e]) * siluf_(bf_lo(zv[it][e])), a * bf_hi(ov[it][e]) * siluf_(bf_hi(zv[it][e])));
          *(u32x4*)(Y + rw * DM + 640 + cc) = w; } }
}

#define XB_TMO      128
#define XB_XCNT(j)  (256  + 64 * (j))
#define XB_XSUB(j)  (1280 + 64 * (j))
#define XB_XGEN(j)  (2304 + 64 * (j))
#define XB_TOP      3328
#define XB_TOPGEN   3392
#define XCD_BAR_WORDS 3456
#define XB_SPIN_CAP (1u << 18)

__device__ __forceinline__ unsigned xb_ld(unsigned* p)              { return __hip_atomic_load(p, __ATOMIC_RELAXED, __HIP_MEMORY_SCOPE_AGENT); }
__device__ __forceinline__ unsigned xb_add(unsigned* p, unsigned v) { return __hip_atomic_fetch_add(p, v, __ATOMIC_RELAXED, __HIP_MEMORY_SCOPE_AGENT); }
__device__ __forceinline__ unsigned xb_xcc_id() { return (unsigned)__builtin_amdgcn_s_getreg((3 << 11) | 20) & 0xFu; }
#define XB_SPIN(cond, bar) do { unsigned _sp = 0; while (cond) { __builtin_amdgcn_s_sleep(1); \
    if ((++_sp & 255u) == 0u) { if (xb_ld(&(bar)[XB_TMO])) break; if (_sp > XB_SPIN_CAP) { atomicAdd(&(bar)[XB_TMO], 1u); break; } } } } while (0)

struct XcdBarrier {
    unsigned* bar; unsigned x;
    volatile LAS unsigned* st;
};

__device__ __forceinline__ XcdBarrier xcd_barrier_post(unsigned* bar, volatile LAS unsigned* st) {
    XcdBarrier b; b.bar = bar; b.x = xb_xcc_id(); b.st = st;
    if (threadIdx.x == 0) (void)xb_add(&bar[XB_XCNT(b.x)], 1u);
    return b;
}
__device__ __forceinline__ void xcd_barrier_complete(unsigned* bar, unsigned x, unsigned& nloc, unsigned& nx) {
    const unsigned G = gridDim.x * gridDim.y * gridDim.z;
    unsigned sum, cnt, mine, sp = 0u;
    for (;;) {
        sum = 0u; cnt = 0u; mine = 0u;
#pragma unroll
        for (unsigned j = 0; j < 16; ++j) { const unsigned c = xb_ld(&bar[XB_XCNT(j)]); sum += c; cnt += (c > 0u) ? 1u : 0u; mine = (j == x) ? c : mine; }
        if (sum == G) break;
        __builtin_amdgcn_s_sleep(1);
        if ((++sp & 255u) == 0u) { if (xb_ld(&bar[XB_TMO])) break; if (sp > XB_SPIN_CAP) { atomicAdd(&bar[XB_TMO], 1u); break; } }
    }
    nloc = mine > 0u ? mine : 1u; nx = cnt > 0u ? cnt : 1u;
}

__device__ __forceinline__ void xcd_barrier(const XcdBarrier& b) {
    asm volatile("s_waitcnt vmcnt(0)" ::: "memory");
    __syncthreads();
    if (threadIdx.x == 0) {
        unsigned* bar = b.bar;
        __builtin_amdgcn_s_waitcnt(0);
        unsigned nloc = b.st[0], nx = b.st[1];
        if (nloc == 0u) { xcd_barrier_complete(bar, b.x, nloc, nx); b.st[0] = nloc; b.st[1] = nx; }
        const unsigned old = xb_add(&bar[XB_XSUB(b.x)], 1u);
        const unsigned gen = old / nloc;
        if (old + 1u == (gen + 1u) * nloc) {
            __builtin_amdgcn_fence(__ATOMIC_RELEASE, "agent");
            asm volatile("s_waitcnt vmcnt(0)" ::: "memory");
            const unsigned og = xb_add(&bar[XB_TOP], 1u);
            const unsigned tg = og / nx;
            if (og + 1u == (tg + 1u) * nx) xb_add(&bar[XB_TOPGEN], 1u);
            else XB_SPIN(xb_ld(&bar[XB_TOPGEN]) == tg, bar);
            __builtin_amdgcn_fence(__ATOMIC_ACQUIRE, "agent");
            xb_add(&bar[XB_XGEN(b.x)], 1u);
            asm volatile("s_waitcnt vmcnt(0)" ::: "memory");
        } else {
            XB_SPIN(xb_ld(&bar[XB_XGEN(b.x)]) == gen, bar);
            __builtin_amdgcn_fence(__ATOMIC_ACQUIRE, "agent");
            asm volatile("s_waitcnt vmcnt(0)" ::: "memory");
        }
    }
    __syncthreads();
}


#ifndef EXTRA_SYNC
#define EXTRA_SYNC 0
#endif
#ifndef DBG_STOP
#define DBG_STOP 0
#endif
#ifndef DBG_DUMP
#define DBG_DUMP 0
#endif
#if DBG_STOP
__device__ __forceinline__ void dbg_dump(const Params& P) {
    unsigned char* ws = P.ws; const size_t total = (size_t)MTOK * DM;
    for (size_t i = (size_t)blockIdx.x * 512 + otid(); i < total; i += (size_t)gridDim.x * 512) {
        const size_t m = i >> 10; const int c = (int)(i & 1023); float v = 0.f;
        if (DBG_DUMP == 0) { const bf16_t* U = (const bf16_t*)(ws + WS_U) + m * NU; v = bf2f(U[c]) + bf2f(U[c + 1024]) + bf2f(U[c + 2048]) + bf2f(U[c + 3072]) + (c < 256 ? bf2f(U[c + 4096]) : 0.f); }
        else if (DBG_DUMP == 1) { v = bf2f(((const bf16_t*)(ws + WS_XY))[m * DM + c]); }
        else if (DBG_DUMP == 2) { v = c < 384 ? bf2f(((const bf16_t*)(ws + WS_OD))[m * 384 + c]) : (c < 390 ? ((const float*)(ws + WS_LSE))[m * 8 + (c - 384)] : (m < 4096 && c < 512 ? bf2f(((const bf16_t*)(ws + WS_KC))[m * 128 + (c - 392)]) : 0.f)); }
        else if (DBG_DUMP == 3) { v = ((const float*)(ws + WS_H1))[i]; }
        else if (DBG_DUMP == 4) { v = bf2f(((const bf16_t*)(ws + WS_PP))[i]); }
        P.out[i] = v; }
}
#endif
constexpr int LDS_BYTES = 147456;
constexpr int NPHASE = 1 + 6 * DEPTH;

__global__ void __launch_bounds__(512) hymba_fwd(Params P) {
    extern __shared__ __attribute__((aligned(16))) unsigned char lds_raw[];
    LAS unsigned char* lds = (LAS unsigned char*)lds_raw;
    unsigned char* ws = P.ws;
    volatile LAS unsigned* bst = (volatile LAS unsigned*)(lds + LDS_BYTES - 64);
    if (threadIdx.x < 2) bst[threadIdx.x] = 0u;
    __syncthreads();
    if (P.ph_hi - P.ph_lo > 1) (void)xcd_barrier_post((unsigned*)(ws + WS_BAR), bst);
    if (P.ph_hi < 0) cg::this_grid().sync();
#define GRID_SYNC() do { XcdBarrier b_; b_.bar = (unsigned*)(P.ws + WS_BAR); b_.x = xb_xcc_id(); b_.st = (volatile LAS unsigned*)(lds + LDS_BYTES - 64); xcd_barrier(b_); } while (0)
    for (int ph = P.ph_lo; ph < P.ph_hi; ++ph) {
        if (ph >= 1 && (ph - 1) % 6 == 5 && (ph - 1) / 6 + 1 < DEPTH) continue;
        if (ph > P.ph_lo) GRID_SYNC();
#if EXTRA_SYNC
        if (ph > P.ph_lo) { for (int e_ = 0; e_ < EXTRA_SYNC; ++e_) GRID_SYNC(); }
#endif
#if DBG_STOP
        if (ph == DBG_STOP) { dbg_dump(P); continue; }
#endif
        if (ph == 0) { phase_prologue(P, lds);
#if REP_SUB & 64
            GRID_SYNC(); phase_prologue(P, lds);
#endif
            continue; }
        const int layer = (ph - 1) / 6, sub = (ph - 1) % 6;
#if REP_SUB
        for (int rep = 0; rep < ((((REP_SUB & 63) >> sub) & 1) ? 2 : 1); ++rep) { if (rep) GRID_SYNC();
#endif
        const bf16_t* a1src = (const bf16_t*)(ws + WS_H2B);
        if (sub == 0) {
            if (layer == 0 && blockIdx.x == 0) { const int t_ = otid(); if (t_ < DEPTH * 2 * 64) { const float* pp_ = (const float*)(ws + WS_C1 + 32768) + (t_ >> 6) * 32 * 64 + (t_ & 63); float a_ = 0.f;
#pragma unroll 8
                for (int c_ = 0; c_ < 32; ++c_) a_ += pp_[c_ * 64];
                ((float*)(ws + WS_C1))[t_] = a_; } }
            pg8::Gemm gm{(const pg8::bf16_t*)a1src, (const pg8::bf16_t*)(ws + WS_WIN) + (size_t)layer * NU * DM, MTOK, 4096, DM};
            pg8::StaticOrder S; S.init(MTOK, 4096, (int)gridDim.x, (int)blockIdx.x);
            EpiUS E{(bf16_t*)(ws + WS_U), NU, (const unsigned long long*)(ws + WS_SS)};
            for (int gh = 0; gh < 2; ++gh) {
                if ((gh == 0) == ((blockIdx.x & 1) != 0)) { const int tid = otid(), lane = tid & 63, wave = tid >> 6;
                    for (int t = blockIdx.x * 8 + wave; t < MTOK / 16; t += gridDim.x * 8) gates_task(P, layer, a1src, t, lane);
                    __syncthreads(); }
                if (gh == 0) pg8::gemm_phase<EpiUS, pg8::StaticOrder, true, true>((PG8_LAS unsigned char*)lds, gm, S, E);
            }
        } else if (sub == 1) {
            const int tid = otid(), lane = tid & 63, wave = tid >> 6;
            for (int u = blockIdx.x; u < 256 + 1536; u += gridDim.x) {
                if (u < 256) { compress_task(P, layer, u * 2 + (wave >> 2), wave & 3, (LAS float*)lds, wave, lane);
#if REP_SUB & 128
                    compress_task(P, layer, u * 2 + (wave >> 2), wave & 3, (LAS float*)lds, wave, lane);
#endif
                } else { dilated_unit(P, u - 256, lds);
#if REP_SUB & 256
                    dilated_unit(P, u - 256, lds);
#endif
                }
            }
            conv_phase(P, layer);
#if REP_SUB & 512
            conv_phase(P, layer);
#endif
        } else if (sub == 2) {
            const int G = (int)gridDim.x, c = (int)blockIdx.x;
            for (int k = 0;; ++k) { const int ir_ = (k + 1) * G - 1 - c; int i = (k & 1) ? ((G & 7) == 0 ? ((ir_ & ~7) | (c & 7)) : ir_) : k * G + c; if (G == 256) i = ((k == 0) != ((c & 8) != 0)) ? 8 * (63 - (c >> 3)) + (c & 7) : c;     if (k * G >= 512) break; if (i >= 512) continue;
                const int qb = 63 - (i >> 3), bg = i & 7; nsa_unit(P, layer, bg >> 1, bg & 1, qb, lds); }
        } else if (sub == 3) {
            { unsigned long long* ss = (unsigned long long*)(ws + WS_SS); for (int i = blockIdx.x * 512 + otid(); i < MTOK; i += gridDim.x * 512) ss[i] = 0ull; }
            for (int it = 0; it < 2; ++it) {
                const bool do_pp = ((it == 0) != ((blockIdx.x & 1) != 0));
                if (do_pp) { int kple = PLE; asm volatile("" : "+s"(kple));
                  pg8::Gemm gm{(const pg8::bf16_t*)(ws + WS_PB) + (size_t)layer * MTOK * PLE, (const pg8::bf16_t*)(ws + WS_WPROJ) + (size_t)layer * DM * PLE, MTOK, DM, kple};
                  pg8::StaticOrder S; S.init(MTOK, DM, (int)gridDim.x, (int)blockIdx.x);
                  EpiU E{(bf16_t*)(ws + WS_PP), DM};
                  pg8::gemm_phase<EpiU, pg8::StaticOrder, true, true>((PG8_LAS unsigned char*)lds, gm, S, E);
                } else { pg8::Gemm gm{(const pg8::bf16_t*)(ws + WS_XY), (const pg8::bf16_t*)(ws + WS_WOUT) + (size_t)layer * DM * DM, MTOK, DM, DM};
                  pg8::StaticOrder S; S.init(MTOK, DM, (int)gridDim.x, (int)blockIdx.x);
                  EpiRes E{(const bf16_t*)(ws + WS_H2B), (bf16_t*)(ws + WS_H1B)};
                  pg8::gemm_phase<EpiRes, pg8::StaticOrder, true, true>((PG8_LAS unsigned char*)lds, gm, S, E); }
                __syncthreads();
            }
        } else if (sub == 4) {
            pg8::Gemm gm{(const pg8::bf16_t*)(ws + WS_H1B), (const pg8::bf16_t*)(ws + WS_WGATE) + (size_t)layer * DM * DM, MTOK, DM, DM};
            pg8::StaticOrder S; S.init(MTOK, DM, (int)gridDim.x, (int)blockIdx.x);
            EpiGate E{(const bf16_t*)(ws + WS_H1B), (const bf16_t*)(ws + WS_PP), (bf16_t*)(ws + WS_H2B), (unsigned long long*)(ws + WS_SS)};
            pg8::gemm_phase<EpiGate, pg8::StaticOrder, true, true>((PG8_LAS unsigned char*)lds, gm, S, E);
        } else {
            const bf16_t* hb = (const bf16_t*)(ws + WS_H2B); const unsigned long long* ss = (const unsigned long long*)(ws + WS_SS);
            const size_t n8 = (size_t)MTOK * DM / 8;
            for (size_t i = (size_t)blockIdx.x * 512 + otid(); i < n8; i += (size_t)gridDim.x * 512) {
                const size_t row = i >> 7; const int c = (int)(i & 127) * 8;
                const float rs = 1.0f / sqrtf((float)ss[row] * SS_INV + RMS_EPS);
                const u32x4 w = *(const u32x4*)(hb + i * 8); const f32x4 g0 = *(const f32x4*)(P.norm_final + c), g1 = *(const f32x4*)(P.norm_final + c + 4);
                f32x4 o0, o1; o0[0] = bf_lo(w.x) * rs * g0[0]; o0[1] = bf_hi(w.x) * rs * g0[1]; o0[2] = bf_lo(w.y) * rs * g0[2]; o0[3] = bf_hi(w.y) * rs * g0[3];
                o1[0] = bf_lo(w.z) * rs * g1[0]; o1[1] = bf_hi(w.z) * rs * g1[1]; o1[2] = bf_lo(w.w) * rs * g1[2]; o1[3] = bf_hi(w.w) * rs * g1[3];
                *(f32x4*)(P.out + i * 8) = o0; *(f32x4*)(P.out + i * 8 + 4) = o1; }
        }
#if REP_SUB
        }
#endif
    }
}

#ifndef ONE_LAUNCH
#define ONE_LAUNCH 0
#endif
extern "C" void kernel_launch(void* const* d_in, const int* in_sizes, int n_in, void* d_out, int out_size, void* d_ws, size_t ws_size, hipStream_t stream) {
    static int grid = 0;
    if (grid == 0) {
        if (n_in != 13 || out_size != MTOK * DM || ws_size < WS_END) { fprintf(stderr, "kernel_launch: unexpected shapes (n_in %d out %d ws %zu)\n", n_in, out_size, ws_size); grid = -1; return; }
        int dev = 0, cus = 0, per_cu = 0;
        hipGetDevice(&dev); hipDeviceGetAttribute(&cus, hipDeviceAttributeMultiprocessorCount, dev);
        if (hipFuncSetAttribute((const void*)hymba_fwd, hipFuncAttributeMaxDynamicSharedMemorySize, LDS_BYTES) != hipSuccess) { fprintf(stderr, "kernel_launch: hipFuncSetAttribute failed\n"); grid = -1; return; }
        if (hipOccupancyMaxActiveBlocksPerMultiprocessor(&per_cu, (const void*)hymba_fwd, 512, LDS_BYTES) != hipSuccess || per_cu < 1) { fprintf(stderr, "kernel_launch: occupancy query says %d\n", per_cu); per_cu = 1; }
        (void)hipGetLastError();
        grid = cus * 1;
    }
    if (grid < 0) return;
    Params p{};
    p.x = (const float*)d_in[0]; p.p = (const float*)d_in[1]; p.norm_mix = (const float*)d_in[2]; p.w_in = (const float*)d_in[3]; p.conv_w = (const float*)d_in[4];
    p.conv_b = (const float*)d_in[5]; p.cmp_pe = (const float*)d_in[6]; p.cmp_w1 = (const float*)d_in[7]; p.cmp_w2 = (const float*)d_in[8]; p.w_out = (const float*)d_in[9];
    p.w_gate = (const float*)d_in[10]; p.w_proj = (const float*)d_in[11]; p.norm_final = (const float*)d_in[12];
    p.out = (float*)d_out; p.ws = (unsigned char*)d_ws;
#if ONE_LAUNCH
    if (hipMemsetAsync((char*)d_ws + WS_BAR, 0, 65536, stream) != hipSuccess) { fprintf(stderr, "kernel_launch: memset of the barrier words failed\n"); return; }
    p.ph_lo = 0; p.ph_hi = NPHASE;
    void* args[] = {&p};
    hipError_t e = hipLaunchCooperativeKernel((const void*)hymba_fwd, dim3(grid), dim3(512), args, LDS_BYTES, stream);
    if (e != hipSuccess) fprintf(stderr, "cooperative launch failed: %s (grid %d)\n", hipGetErrorString(e), grid);
#else
    for (int ph = 0; ph < (DBG_STOP ? DBG_STOP + 1 : NPHASE); ++ph) { p.ph_lo = ph; p.ph_hi = ph + 1; hipLaunchKernelGGL(hymba_fwd, dim3(grid), dim3(512), LDS_BYTES, stream, p); }
#endif
}
```
